# Optimizing an MI355X kernel written in HIP

```python
import jax, jax.numpy as jnp
from jax import lax
import numpy as np

D_MODEL = 2048
BATCH = 16
SEQ = 2048
DEPTH = 4

A_HEADS = D_MODEL // 256
A_KEY_DIM = 128
A_VAL_DIM = 128
A_KEY_WIDTH = A_HEADS * A_KEY_DIM
A_VAL_WIDTH = A_HEADS * A_VAL_DIM
A_CHUNK = 32
B_GROUPS = D_MODEL // 256
B_GROUP_DIM = 128
B_WIDTH = B_GROUPS * B_GROUP_DIM
B_CHUNK = 128
FF_HIDDEN = 4 * D_MODEL
N_MOD = 6
EPS = 1e-6
MIN_FORGET = 1e-20
IN_SIZES = (A_KEY_WIDTH, A_KEY_WIDTH, A_VAL_WIDTH, A_VAL_WIDTH, B_WIDTH, B_WIDTH, D_MODEL, D_MODEL)
IN_WIDTH = 2 * A_KEY_WIDTH + 2 * A_VAL_WIDTH + 2 * B_WIDTH + 2 * D_MODEL

kernel_name = "hgrn2_gmlp_gated_hybrid_adaln"


def _split_points():
    pts, acc = [], 0
    for s in IN_SIZES[:-1]:
        acc += s
        pts.append(acc)
    return pts


def rms_norm(x, g):
    xf = x.astype(jnp.float32)
    y = xf * lax.rsqrt(jnp.mean(xf * xf, axis=-1, keepdims=True) + EPS)
    return (y * g.astype(jnp.float32)).astype(x.dtype)


def layer_norm(x, g, b):
    xf = x.astype(jnp.float32)
    mu = jnp.mean(xf, axis=-1, keepdims=True)
    var = jnp.mean(jnp.square(xf - mu), axis=-1, keepdims=True)
    y = (xf - mu) * lax.rsqrt(var + EPS)
    return (y * g.astype(jnp.float32) + b.astype(jnp.float32)).astype(x.dtype)


def modulate(h, shift, scale):
    return h * (1.0 + scale[:, None, :]) + shift[:, None, :]


def hgrn2_chunkwise(q, k, v, log_f):
    Bn, T, H, K = q.shape
    V = v.shape[-1]
    n = T // A_CHUNK

    def to_chunks(a):
        return a.reshape(Bn, n, A_CHUNK, H, a.shape[-1]).transpose(1, 0, 3, 2, 4)

    causal = jnp.tril(jnp.ones((A_CHUNK, A_CHUNK), dtype=bool))[:, :, None]
    causal_f = causal.astype(jnp.float32)

    def step(S, inp):
        qc, kc, vc, lc = inp
        b = jnp.cumsum(lc, axis=2)
        o_inter = jnp.einsum('bhtk,bhkv->bhtv', qc * jnp.exp(b), S)
        diff = b[:, :, :, None, :] - b[:, :, None, :, :]
        decay = jnp.exp(jnp.where(causal, diff, 0.0)) * causal_f
        scores = jnp.einsum('bhtk,bhsk,bhtsk->bhts', qc, kc, decay)
        o = o_inter + jnp.einsum('bhts,bhsv->bhtv', scores, vc)
        b_last = b[:, :, -1:, :]
        S_new = jnp.exp(b_last[:, :, 0, :, None]) * S + jnp.einsum(
            'bhsk,bhsv->bhkv', kc * jnp.exp(b_last - b), vc)
        return S_new, o

    S0 = jnp.zeros((Bn, H, K, V), dtype=jnp.float32)
    _, o = lax.scan(step, S0, (to_chunks(q), to_chunks(k), to_chunks(v), to_chunks(log_f)))
    return o.transpose(1, 0, 3, 2, 4).reshape(Bn, T, H, V)


def hgrn2_mixer(q_raw, f_raw, i_raw, g_raw, lb, norm_g):
    Bn, T, _ = q_raw.shape
    f32 = jnp.float32
    q = jax.nn.silu(q_raw.astype(f32)).reshape(Bn, T, A_HEADS, A_KEY_DIM)
    fl = f_raw.astype(f32)
    lbf = lb.astype(f32)
    f = lbf + (1.0 - lbf) * jax.nn.sigmoid(fl)
    log_f = jnp.log(jnp.maximum(f, MIN_FORGET))
    k = (1.0 - lbf) * jax.nn.sigmoid(-fl)
    log_f = log_f.reshape(Bn, T, A_HEADS, A_KEY_DIM)
    k = k.reshape(Bn, T, A_HEADS, A_KEY_DIM)
    v = i_raw.astype(f32).reshape(Bn, T, A_HEADS, A_VAL_DIM)
    o = hgrn2_chunkwise(q, k, v, log_f)
    o = rms_norm(o, norm_g).reshape(Bn, T, A_VAL_WIDTH)
    o = o * jax.nn.silu(g_raw.astype(f32))
    return o.astype(q_raw.dtype)


def spatial_gating(u_raw, v_raw, ln_g, ln_b, w_s, b_s):
    Bn, T, _ = v_raw.shape
    n = T // B_CHUNK
    u = jax.nn.gelu(u_raw, approximate=False)
    v = layer_norm(jax.nn.gelu(v_raw, approximate=False), ln_g, ln_b)
    v = v.reshape(Bn, n, B_CHUNK, B_GROUPS, B_GROUP_DIM)
    w = w_s * jnp.tril(jnp.ones((B_CHUNK, B_CHUNK), dtype=w_s.dtype))[None]
    s = jnp.einsum('gts,bnsgd->bntgd', w, v) + b_s.T[None, None, :, :, None]
    return u * s.reshape(Bn, T, B_WIDTH)


def setup_inputs(seed: int = 0) -> dict:
    key = jax.random.key(seed)
    ks = jax.random.split(key, 20)
    nrm = jax.random.normal
    f32 = jnp.float32
    D, L = D_MODEL, DEPTH
    return {
        'x': nrm(ks[0], (BATCH, SEQ, D), f32),
        'c': nrm(ks[1], (BATCH, D), f32),
        'w_ada': nrm(ks[2], (L, D, N_MOD * D), f32) * (0.5 * D ** -0.5),
        'b_ada': nrm(ks[3], (L, N_MOD * D), f32) * 0.02,
        'norm1_g': 1.0 + 0.02 * nrm(ks[4], (L, D), f32),
        'norm2_g': 1.0 + 0.02 * nrm(ks[5], (L, D), f32),
        'w_in': nrm(ks[6], (L, D, IN_WIDTH), f32) * D ** -0.5,
        'hgrn_lower_bounds': 0.5 * nrm(ks[7], (L, A_KEY_WIDTH), f32),
        'hgrn_norm_g': 1.0 + 0.02 * nrm(ks[8], (L, A_VAL_DIM), f32),
        'ln_v_g': 1.0 + 0.02 * nrm(ks[9], (L, B_WIDTH), f32),
        'ln_v_b': 0.02 * nrm(ks[10], (L, B_WIDTH), f32),
        'w_spatial': nrm(ks[11], (L, B_GROUPS, B_CHUNK, B_CHUNK), f32) * B_CHUNK ** -0.5,
        'b_spatial': 1.0 + 0.02 * nrm(ks[12], (L, B_GROUPS, B_CHUNK), f32),
        'w_proj_a': nrm(ks[13], (L, A_VAL_WIDTH, D), f32) * A_VAL_WIDTH ** -0.5,
        'w_proj_b': nrm(ks[14], (L, B_WIDTH, D), f32) * B_WIDTH ** -0.5,
        'w_out': nrm(ks[15], (L, D, D), f32) * D ** -0.5,
        'w_ff_in': nrm(ks[16], (L, D, FF_HIDDEN), f32) * D ** -0.5,
        'w_ff_out': nrm(ks[17], (L, FF_HIDDEN, D), f32) * FF_HIDDEN ** -0.5,
        'final_norm_g': 1.0 + 0.02 * nrm(ks[18], (D,), f32),
    }


def reference(x, c, w_ada, b_ada, norm1_g, norm2_g, w_in, hgrn_lower_bounds, hgrn_norm_g,
              ln_v_g, ln_v_b, w_spatial, b_spatial, w_proj_a, w_proj_b, w_out,
              w_ff_in, w_ff_out, final_norm_g):
    split_pts = _split_points()
    p = jax.nn.softmax(hgrn_lower_bounds.astype(jnp.float32), axis=0)
    lower_bounds = jnp.cumsum(p, axis=0) - p[0:1]
    c_act = jax.nn.silu(c)
    for l in range(DEPTH):
        mod = c_act @ w_ada[l] + b_ada[l]
        sh1, sc1, gt1, sh2, sc2, gt2 = jnp.split(mod, N_MOD, axis=-1)
        h = modulate(rms_norm(x, norm1_g[l]), sh1, sc1)
        proj = h @ w_in[l]
        q_r, f_r, i_r, g_r, u_r, v_r, ga_r, gb_r = jnp.split(proj, split_pts, axis=-1)
        y_a = hgrn2_mixer(q_r, f_r, i_r, g_r, lower_bounds[l], hgrn_norm_g[l]) @ w_proj_a[l]
        y_b = spatial_gating(u_r, v_r, ln_v_g[l], ln_v_b[l], w_spatial[l], b_spatial[l]) @ w_proj_b[l]
        merged = jax.nn.sigmoid(ga_r) * y_a + jax.nn.sigmoid(gb_r) * y_b
        x = x + gt1[:, None, :] * (merged @ w_out[l])
        h = modulate(rms_norm(x, norm2_g[l]), sh2, sc2)
        ff = jnp.square(jax.nn.relu(h @ w_ff_in[l])) @ w_ff_out[l]
        x = x + gt2[:, None, :] * ff
    return rms_norm(x, final_norm_g)
```

```cpp
#include <hip/hip_runtime.h>
#include <cstdio>
#include <cstdint>
namespace pg8 {
#define PG8_LAS __attribute__((address_space(3)))
typedef unsigned short bf16_t;
typedef short bf16x8 __attribute__((ext_vector_type(8)));
typedef float f32x4 __attribute__((ext_vector_type(4)));
typedef unsigned u32x4 __attribute__((ext_vector_type(4)));
constexpr int BM = 256, BK = 64, HALF = 128, HTB = HALF * BK * 2  , STAGE_BYTES = 8 * HTB, NXCD = 8, WGM = 8;

__host__ __device__ __forceinline__ int lds_byte(int r, int c) { const int st = (r >> 4) * 2 + (c >> 5), rr = r & 15, cc = c & 31, ob = rr * 64 + cc * 2; return st * 1024 + (ob ^ (((ob >> 9) & 1) << 5)); }
__host__ __device__ __forceinline__ void stage_rc(int b, int& R, int& C) { const int st = b / 1024, sb = b % 1024, swz = sb ^ (((sb >> 9) & 1) << 5); R = (st >> 1) * 16 + swz / 64; C = (st & 1) * 32 + (swz % 64) / 2; }
__host__ __device__ __forceinline__ int perm32(int rho) { const int n = rho >> 4, i = rho & 15; return 8 * (i >> 2) + 4 * n + (i & 3); }

struct Unit { int pm, pn; };
struct Gemm { const bf16_t* A; const bf16_t* Bt; int M, N, K; };

struct StaticOrder {
    int nM, nN, nwg, G, c;
    __host__ __device__ void init(int M, int N, int G_, int c_) { nM = M / BM; nN = N / BM; nwg = nM * nN; G = G_; c = c_; }
    __host__ __device__ bool next(int i, Unit& u) const {
        const long L = (long)i * G + c; if (L >= nwg) return false;
        int wgid = (int)L; { const int q = nwg / NXCD, r = nwg % NXCD, xcd = wgid % NXCD, off = wgid / NXCD; wgid = (xcd < r ? xcd * (q + 1) : r * (q + 1) + (xcd - r) * q) + off; }
        const int nig = WGM * nN, gid = wgid / nig, fm = gid * WGM, gsz = (nM - fm) < WGM ? (nM - fm) : WGM;
        u.pm = fm + ((wgid % nig) % gsz); u.pn = (wgid % nig) / gsz; return true;
    }
    __device__ __forceinline__ void a_ready(const Unit&) const {}
    __device__ __forceinline__ void done(const Unit&) const {}
};
typedef float f32x2 __attribute__((ext_vector_type(2)));
typedef __bf16 bf16x2_t __attribute__((ext_vector_type(2)));
__device__ __forceinline__ unsigned cvt_pk_bf16(float lo, float hi) { const f32x2 v = {lo, hi}; return __builtin_bit_cast(unsigned, __builtin_convertvector(v, bf16x2_t)); }
__device__ __forceinline__ f32x2 gelu_pk(f32x2 v) {
    const f32x2 av = __builtin_elementwise_abs(v), d = av * 0.2316418882f + 1.0f;
    f32x2 t; t.x = __builtin_amdgcn_rcpf(d.x); t.y = __builtin_amdgcn_rcpf(d.y);
    f32x2 q = t * 0.5307027145f + (-0.7265760135f); q = q * t + 0.7107068705f; q = q * t + (-0.142248368f); q = q * t + 0.127414796f; q = q * t;
    const f32x2 s = (v * v) * (-0.72134752044f);
    f32x2 e; e.x = __builtin_amdgcn_exp2f(s.x); e.y = __builtin_amdgcn_exp2f(s.y);
    const f32x2 m = v * (q * e), r = v - m;
    f32x2 o; o.x = v.x < 0.f ? m.x : r.x; o.y = v.y < 0.f ? m.y : r.y; return o;
}

__device__ __forceinline__ float fsigmoid(float x) { return __builtin_amdgcn_rcpf(1.0f + __builtin_amdgcn_exp2f(-1.44269504089f * x)); }
__device__ __forceinline__ float bf_lo(unsigned w) { return __uint_as_float(w << 16); }
__device__ __forceinline__ float bf_hi(unsigned w) { return __uint_as_float(w & 0xffff0000u); }
template <int ACT> __device__ __forceinline__ void act8(f32x4& v0, f32x4& v1) {
    if (ACT == 1) {
#pragma unroll
        for (int j = 0; j < 4; ++j) { v0[j] = v0[j] * fsigmoid(v0[j]); v1[j] = v1[j] * fsigmoid(v1[j]); } }
    if (ACT == 2) { f32x2 a = gelu_pk((f32x2){v0[0], v0[1]}), b = gelu_pk((f32x2){v0[2], v0[3]}), c = gelu_pk((f32x2){v1[0], v1[1]}), d = gelu_pk((f32x2){v1[2], v1[3]});
        v0 = (f32x4){a.x, a.y, b.x, b.y}; v1 = (f32x4){c.x, c.y, d.x, d.y}; }
    if (ACT == 3) {
#pragma unroll
        for (int j = 0; j < 4; ++j) { v0[j] = fsigmoid(v0[j]); v1[j] = fsigmoid(v1[j]); } }
    if (ACT == 4) {
#pragma unroll
        for (int j = 0; j < 4; ++j) { const float a = fmaxf(v0[j], 0.f), b = fmaxf(v1[j], 0.f); v0[j] = a * a; v1[j] = b * b; } }
}
template <int ACT> __device__ __forceinline__ void store_act(const f32x4 (&acc)[2][2][4][2], bf16_t* dst, int ldc, int row0, int col0) {
#pragma unroll
    for (int ai = 0; ai < 2; ++ai)
#pragma unroll
        for (int m = 0; m < 4; ++m) { bf16_t* rowp = dst + (size_t)(row0 + ai * HALF + m * 16) * ldc + col0;
#pragma unroll
            for (int bj = 0; bj < 2; ++bj) { f32x4 v0 = acc[ai][bj][m][0], v1 = acc[ai][bj][m][1];
                act8<ACT>(v0, v1);
                u32x4 w; w.x = cvt_pk_bf16(v0[0], v0[1]); w.y = cvt_pk_bf16(v0[2], v0[3]); w.z = cvt_pk_bf16(v1[0], v1[1]); w.w = cvt_pk_bf16(v1[2], v1[3]);
                *(u32x4*)(rowp + bj * HALF) = w; } }
}
struct EpiProj {
    static constexpr bool PERM = true, AFTER_DRAIN = false;
    bf16_t *Qb, *Kb, *Vb, *Gb, *Ub, *Vgb, *GA, *GB; float* LF; const float* lb;
    __device__ __forceinline__ void operator()(const f32x4 (&acc)[2][2][4][2], const Unit& u, int wr, int wc, int fr, int fq) const {
        const int seg = u.pn >> 2, row0 = u.pm * BM + wr * 64 + fr, cw = wc * 32 + 8 * fq, c4 = (u.pn & 3) * BM + cw;
        if (seg == 1) {
            f32x4 l0[2], l1[2];
#pragma unroll
            for (int bj = 0; bj < 2; ++bj) { l0[bj] = *(const f32x4*)(lb + c4 + bj * HALF); l1[bj] = *(const f32x4*)(lb + c4 + bj * HALF + 4); }
#pragma unroll
            for (int ai = 0; ai < 2; ++ai)
#pragma unroll
                for (int m = 0; m < 4; ++m) { const size_t ro = (size_t)(row0 + ai * HALF + m * 16) * 1024 + c4;
#pragma unroll
                    for (int bj = 0; bj < 2; ++bj) { f32x4 v0 = acc[ai][bj][m][0], v1 = acc[ai][bj][m][1], g0, g1;
#pragma unroll
                        for (int j = 0; j < 4; ++j) {
                            { const float x = fminf(fmaxf(v0[j], -80.f), 80.f), e = __builtin_amdgcn_exp2f(-1.44269504089f * x), s = __builtin_amdgcn_rcpf(1.0f + e), lbv = l0[bj][j], om = 1.0f - lbv;
                              g0[j] = 0.69314718056f * __builtin_amdgcn_logf(fmaxf(lbv + om * s, 1e-20f)); v0[j] = om * (e * s); }
                            { const float x = fminf(fmaxf(v1[j], -80.f), 80.f), e = __builtin_amdgcn_exp2f(-1.44269504089f * x), s = __builtin_amdgcn_rcpf(1.0f + e), lbv = l1[bj][j], om = 1.0f - lbv;
                              g1[j] = 0.69314718056f * __builtin_amdgcn_logf(fmaxf(lbv + om * s, 1e-20f)); v1[j] = om * (e * s); } }
                        u32x4 w; w.x = cvt_pk_bf16(v0[0], v0[1]); w.y = cvt_pk_bf16(v0[2], v0[3]); w.z = cvt_pk_bf16(v1[0], v1[1]); w.w = cvt_pk_bf16(v1[2], v1[3]);
                        *(u32x4*)(Kb + ro + bj * HALF) = w; *(f32x4*)(LF + ro + bj * HALF) = g0; *(f32x4*)(LF + ro + bj * HALF + 4) = g1; } }
            return;
        }
        if (seg == 0) store_act<1>(acc, Qb, 1024, row0, c4);
        else if (seg == 2) store_act<0>(acc, Vb, 1024, row0, c4);
        else if (seg == 3) store_act<1>(acc, Gb, 1024, row0, c4);
        else if (seg == 4) store_act<2>(acc, Ub, 1024, row0, c4);
        else if (seg == 5) store_act<2>(acc, Vgb, 1024, row0, c4);
        else if (seg < 8) store_act<3>(acc, GA, 2048, row0, (u.pn - 24) * BM + cw);
        else store_act<3>(acc, GB, 2048, row0, (u.pn - 32) * BM + cw);
    }
};
template <bool ADD> struct EpiMerge {
    static constexpr bool PERM = true, AFTER_DRAIN = false;
    const bf16_t* gate; bf16_t* out;
    __device__ __forceinline__ void operator()(const f32x4 (&acc)[2][2][4][2], const Unit& u, int wr, int wc, int fr, int fq) const {
        const int row0 = u.pm * BM + wr * 64 + fr, col0 = u.pn * BM + wc * 32 + 8 * fq;
#pragma unroll
        for (int ai = 0; ai < 2; ++ai)
#pragma unroll
            for (int m = 0; m < 4; ++m) { const size_t ro = (size_t)(row0 + ai * HALF + m * 16) * 2048 + col0;
#pragma unroll
                for (int bj = 0; bj < 2; ++bj) { f32x4 v0 = acc[ai][bj][m][0], v1 = acc[ai][bj][m][1];
                    const u32x4 g = *(const u32x4*)(gate + ro + bj * HALF);
                    v0[0] *= bf_lo(g.x); v0[1] *= bf_hi(g.x); v0[2] *= bf_lo(g.y); v0[3] *= bf_hi(g.y); v1[0] *= bf_lo(g.z); v1[1] *= bf_hi(g.z); v1[2] *= bf_lo(g.w); v1[3] *= bf_hi(g.w);
                    if (ADD) { const u32x4 o = *(const u32x4*)(out + ro + bj * HALF);
                        v0[0] += bf_lo(o.x); v0[1] += bf_hi(o.x); v0[2] += bf_lo(o.y); v0[3] += bf_hi(o.y); v1[0] += bf_lo(o.z); v1[1] += bf_hi(o.z); v1[2] += bf_lo(o.w); v1[3] += bf_hi(o.w); }
                    u32x4 w; w.x = cvt_pk_bf16(v0[0], v0[1]); w.y = cvt_pk_bf16(v0[2], v0[3]); w.z = cvt_pk_bf16(v1[0], v1[1]); w.w = cvt_pk_bf16(v1[2], v1[3]);
                    *(u32x4*)(out + ro + bj * HALF) = w; }
                asm volatile("" ::: "memory"); }
    }
};
struct EpiResid {
    static constexpr bool PERM = false, AFTER_DRAIN = false;
    const float* xin; float* xout; const float* gt;
    __device__ __forceinline__ void operator()(const f32x4 (&acc)[2][2][4][2], const Unit& u, int wr, int wc, int fr, int fq) const {
        const int row0 = u.pm * BM + wr * 64 + fr, col0 = u.pn * BM + wc * 32 + 4 * fq, b = u.pm >> 3;
        f32x4 gv[2][2];
#pragma unroll
        for (int bj = 0; bj < 2; ++bj)
#pragma unroll
            for (int n = 0; n < 2; ++n) gv[bj][n] = *(const f32x4*)(gt + (size_t)b * 12288 + col0 + bj * HALF + n * 16);
#pragma unroll
        for (int ai = 0; ai < 2; ++ai)
#pragma unroll
            for (int m = 0; m < 4; ++m) { const size_t ro = (size_t)(row0 + ai * HALF + m * 16) * 2048 + col0;
#pragma unroll
                for (int bj = 0; bj < 2; ++bj)
#pragma unroll
                    for (int n = 0; n < 2; ++n) { const f32x4 xv = *(const f32x4*)(xin + ro + bj * HALF + n * 16); *(f32x4*)(xout + ro + bj * HALF + n * 16) = xv + gv[bj][n] * acc[ai][bj][m][n]; }
                asm volatile("" ::: "memory"); }
    }
};
struct EpiRelu2 {
    static constexpr bool PERM = true, AFTER_DRAIN = false;
    bf16_t* out;
    __device__ __forceinline__ void operator()(const f32x4 (&acc)[2][2][4][2], const Unit& u, int wr, int wc, int fr, int fq) const {
        store_act<4>(acc, out, 8192, u.pm * BM + wr * 64 + fr, u.pn * BM + wc * 32 + 8 * fq);
    }
};

template <class Epi, class Sched, bool ALIGN_EPI = false, bool SP2 = false>
__device__ __forceinline__ void gemm_phase(PG8_LAS unsigned char* lds, const Gemm g, const Sched& S, const Epi& E) {
    int tid_ = threadIdx.x; asm volatile("" : "+v"(tid_));
    const int tid = tid_, wid = __builtin_amdgcn_readfirstlane(tid >> 6), lane = tid & 63, wr = wid >> 2, wc = wid & 3, fr = lane & 15, fq = lane >> 4;
    const int K = g.K, nt = K / BK;
    unsigned voffA[2], voffB[2];
#pragma unroll
    for (int i = 0; i < 2; ++i) { int R, C; stage_rc(tid * 16 + i * 8192, R, C); const int Rb = Epi::PERM ? ((R & ~31) + perm32(R & 31)) : R;
        voffA[i] = (unsigned)(R * K + C) * 2u; voffB[i] = (unsigned)(Rb * K + C) * 2u; }
    const size_t kstep = (size_t)(BK * 2);
    const size_t hstep = (size_t)HALF * K * 2;
    const size_t tstep = 2 * hstep;
    const unsigned ldsw = (unsigned)wid * 1024u;
    const int aoff = lds_byte(wr * 64 + fr, fq * 8), boff = lds_byte(wc * 32 + fr, fq * 8);
#define PG8_SA(b, h) (((b) * 2 + (h)) * HTB)
#define PG8_SB(b, h) ((4 + (b) * 2 + (h)) * HTB)
#define PG8_STAGE(bufoff, gbase, voff) do { _Pragma("unroll") for (int _i = 0; _i < 2; ++_i) \
        __builtin_amdgcn_global_load_lds((const unsigned*)((const char*)(gbase) + (voff)[_i]), (PG8_LAS unsigned*)(lds + (bufoff) + ldsw + _i * 8192), 16, 0, 0); } while (0)
#define PG8_LDA(dst, b, h) do { _Pragma("unroll") for (int m = 0; m < 4; ++m) _Pragma("unroll") for (int k = 0; k < 2; ++k) dst[m][k] = *(const PG8_LAS bf16x8*)(lds + PG8_SA(b, h) + aoff + m * 2048 + k * 1024); } while (0)
#define PG8_LDB(dst, b, h) do { _Pragma("unroll") for (int n = 0; n < 2; ++n) _Pragma("unroll") for (int k = 0; k < 2; ++k) dst[n][k] = *(const PG8_LAS bf16x8*)(lds + PG8_SB(b, h) + boff + n * 2048 + k * 1024); } while (0)
#define PG8_MMA(ai, bj, At, Bt) do { __builtin_amdgcn_s_setprio(1); _Pragma("unroll") for (int m = 0; m < 4; ++m) _Pragma("unroll") for (int n = 0; n < 2; ++n) _Pragma("unroll") for (int k = 0; k < 2; ++k) \
        acc[ai][bj][m][n] = __builtin_amdgcn_mfma_f32_16x16x32_bf16(Bt[n][k], At[m][k], acc[ai][bj][m][n], 0, 0, 0); __builtin_amdgcn_s_setprio(0); } while (0)
#define PG8_WAIT_V(n) asm volatile("s_waitcnt vmcnt(" #n ")" ::: "memory")
#define PG8_WAIT_L(n) asm volatile("s_waitcnt lgkmcnt(" #n ")" ::: "memory")
#define PG8_BAR __builtin_amdgcn_s_barrier()
#define PG8_SCHED __builtin_amdgcn_sched_barrier(0)
    Unit cur, nxt; int ui = 0;
    if (!S.next(0, cur)) return;
    f32x4 acc[2][2][4][2];
#pragma unroll
    for (int a = 0; a < 2; ++a)
#pragma unroll
        for (int b = 0; b < 2; ++b)
#pragma unroll
            for (int m = 0; m < 4; ++m)
#pragma unroll
                for (int n = 0; n < 2; ++n) acc[a][b][m][n] = (f32x4){0.f, 0.f, 0.f, 0.f};
    bf16x8 At[4][2], B0[2][2], B1[2][2];
    const char* cA = (const char*)g.A + (size_t)cur.pm * tstep; const char* cB = (const char*)g.Bt + (size_t)cur.pn * tstep;
    S.a_ready(cur);
    if constexpr (SP2) {
        PG8_STAGE(PG8_SB(0, 0), cB, voffB); PG8_STAGE(PG8_SB(0, 1), cB + hstep, voffB); PG8_STAGE(PG8_SA(0, 0), cA, voffA); PG8_STAGE(PG8_SA(0, 1), cA + hstep, voffA);
        if (wr == 1) PG8_BAR;
        PG8_WAIT_V(2); PG8_BAR;
        PG8_STAGE(PG8_SB(1, 0), cB + kstep, voffB); PG8_STAGE(PG8_SA(1, 0), cA + kstep, voffA); PG8_STAGE(PG8_SB(1, 1), cB + hstep + kstep, voffB);
        PG8_WAIT_V(6); PG8_BAR;
    } else {
        PG8_STAGE(PG8_SB(0, 0), cB, voffB); PG8_STAGE(PG8_SA(0, 0), cA, voffA); PG8_STAGE(PG8_SB(0, 1), cB + hstep, voffB); PG8_STAGE(PG8_SA(0, 1), cA + hstep, voffA);
        if (wr == 1) PG8_BAR;
        PG8_WAIT_V(4); PG8_BAR;
        PG8_STAGE(PG8_SB(1, 0), cB + kstep, voffB); PG8_STAGE(PG8_SA(1, 0), cA + kstep, voffA); PG8_STAGE(PG8_SB(1, 1), cB + hstep + kstep, voffB);
        PG8_WAIT_V(6); PG8_BAR;
    }
    for (;;) {
        const bool has_next = S.next(ui + 1, nxt);
        const char* nA = has_next ? (const char*)g.A + (size_t)nxt.pm * tstep : cA; const char* nB = has_next ? (const char*)g.Bt + (size_t)nxt.pn * tstep : cB;
        for (int t = 0; t < nt; t += 2) {
            const bool last = (t == nt - 2);
            const char* a1 = cA + (size_t)(t + 1) * kstep;
            const char* a2 = last ? nA : cA + (size_t)(t + 2) * kstep; const char* b2 = last ? nB : cB + (size_t)(t + 2) * kstep;
            const char* a3 = a2 + kstep; const char* b3 = b2 + kstep;
            if (last && has_next) S.a_ready(nxt);
            if constexpr (SP2) {
            PG8_LDB(B0, 0, 0); PG8_LDB(B1, 0, 1); PG8_SCHED; PG8_LDA(At, 0, 0); PG8_STAGE(PG8_SA(1, 1), a1 + hstep, voffA);
            PG8_WAIT_V(8); PG8_WAIT_L(0); PG8_BAR; PG8_MMA(0, 0, At, B0); PG8_MMA(0, 1, At, B1); PG8_BAR; PG8_SCHED;
            PG8_LDA(At, 0, 1); PG8_STAGE(PG8_SB(0, 0), b2, voffB); PG8_STAGE(PG8_SB(0, 1), b2 + hstep, voffB); PG8_STAGE(PG8_SA(0, 0), a2, voffA);
            PG8_WAIT_V(8); PG8_WAIT_L(0); PG8_BAR; PG8_MMA(1, 0, At, B0); PG8_MMA(1, 1, At, B1); PG8_BAR; PG8_SCHED;
            PG8_LDB(B0, 1, 0); PG8_LDB(B1, 1, 1); PG8_SCHED; PG8_LDA(At, 1, 0); PG8_STAGE(PG8_SA(0, 1), a2 + hstep, voffA);
            PG8_WAIT_V(8); PG8_WAIT_L(0); PG8_BAR; PG8_MMA(0, 0, At, B0); PG8_MMA(0, 1, At, B1); PG8_BAR; PG8_SCHED;
            PG8_LDA(At, 1, 1); PG8_STAGE(PG8_SB(1, 0), b3, voffB); PG8_STAGE(PG8_SB(1, 1), b3 + hstep, voffB); PG8_STAGE(PG8_SA(1, 0), a3, voffA);
            PG8_WAIT_V(8); PG8_WAIT_L(0); PG8_BAR; PG8_MMA(1, 0, At, B0); PG8_MMA(1, 1, At, B1); PG8_BAR; PG8_SCHED;
            } else {
            PG8_LDB(B0, 0, 0); PG8_SCHED; PG8_LDA(At, 0, 0); PG8_STAGE(PG8_SA(1, 1), a1 + hstep, voffA);
            PG8_WAIT_L(8); PG8_BAR; PG8_WAIT_L(0); PG8_MMA(0, 0, At, B0); PG8_BAR; PG8_SCHED;
            PG8_LDB(B1, 0, 1); PG8_STAGE(PG8_SB(0, 0), b2, voffB);
            PG8_BAR; PG8_WAIT_L(0); PG8_MMA(0, 1, At, B1); PG8_BAR;
            PG8_LDA(At, 0, 1); PG8_STAGE(PG8_SA(0, 0), a2, voffA);
            PG8_BAR; PG8_WAIT_L(0); PG8_MMA(1, 0, At, B0); PG8_BAR; PG8_SCHED;
            PG8_STAGE(PG8_SB(0, 1), b2 + hstep, voffB);
            PG8_WAIT_V(6); PG8_BAR; PG8_MMA(1, 1, At, B1); PG8_BAR;
            PG8_LDB(B0, 1, 0); PG8_SCHED; PG8_LDA(At, 1, 0); PG8_STAGE(PG8_SA(0, 1), a2 + hstep, voffA);
            PG8_WAIT_L(8); PG8_BAR; PG8_WAIT_L(0); PG8_MMA(0, 0, At, B0); PG8_BAR; PG8_SCHED;
            PG8_LDB(B1, 1, 1); PG8_STAGE(PG8_SB(1, 0), b3, voffB);
            PG8_BAR; PG8_WAIT_L(0); PG8_MMA(0, 1, At, B1); PG8_BAR;
            PG8_LDA(At, 1, 1); PG8_STAGE(PG8_SA(1, 0), a3, voffA);
            PG8_BAR; PG8_WAIT_L(0); PG8_MMA(1, 0, At, B0); PG8_BAR; PG8_SCHED;
            PG8_STAGE(PG8_SB(1, 1), b3 + hstep, voffB);
            PG8_WAIT_V(6); PG8_BAR; PG8_MMA(1, 1, At, B1); PG8_BAR;
            }
        }
        if constexpr (ALIGN_EPI) { if (wr == 0) PG8_BAR; }
        if constexpr (!Epi::AFTER_DRAIN) { E(acc, cur, wr, wc, fr, fq); S.done(cur); }
        if (!has_next) break;
#pragma unroll
        for (int a = 0; a < 2; ++a)
#pragma unroll
            for (int b = 0; b < 2; ++b)
#pragma unroll
                for (int m = 0; m < 4; ++m)
#pragma unroll
                    for (int n = 0; n < 2; ++n) acc[a][b][m][n] = (f32x4){0.f, 0.f, 0.f, 0.f};
        cur = nxt; cA = nA; cB = nB; ++ui;
        if constexpr (ALIGN_EPI) { if (wr == 1) PG8_BAR; }
    }
    PG8_WAIT_V(0);
    if constexpr (!ALIGN_EPI) { if (wr == 0) PG8_BAR; }
    PG8_BAR;
    if constexpr (Epi::AFTER_DRAIN) { E.fused(acc, cur, wr, wc, fr, fq, lds, wid, lane); S.done(cur); }
#undef PG8_SA
#undef PG8_SB
#undef PG8_STAGE
#undef PG8_LDA
#undef PG8_LDB
#undef PG8_MMA
#undef PG8_WAIT_V
#undef PG8_WAIT_L
#undef PG8_BAR
#undef PG8_SCHED
}
}

constexpr int NWAVES = 8;
constexpr int BATCH = 16, SEQ = 2048, D = 2048, DEPTH = 4, AW = 1024, INW = 10240, FF = 8192, NMODC = 6 * D;
constexpr int M = BATCH * SEQ;
constexpr float EPS = 1e-6f;
#ifndef MK_SINGLE
#define MK_SINGLE 1
#endif
constexpr int N_PHASES = 2 + 9 * DEPTH + 1;

constexpr size_t MiB = 1u << 20;
constexpr size_t WS_CTL = 0, CTL_ZERO_BYTES = 1 * MiB;
constexpr size_t WS_MOD = 1 * MiB;
constexpr size_t WS_LB = 4 * MiB;
constexpr size_t WS_W = 8 * MiB, W_LAYER = 120 * MiB;
constexpr size_t WO_IN = 0, WO_A = 40 * MiB, WO_B = 44 * MiB, WO_OUT = 48 * MiB, WO_F1 = 56 * MiB, WO_F2 = 88 * MiB;
constexpr size_t WS_ACT = WS_W + DEPTH * W_LAYER;
constexpr size_t WS_OG = WS_ACT + 128 * MiB;
constexpr size_t WS_SG = WS_OG + 64 * MiB;
constexpr size_t WS_PROJ = WS_SG + 64 * MiB;
constexpr size_t WS_Q = WS_PROJ, WS_K = WS_Q + 64 * MiB, WS_LF = WS_K + 64 * MiB, WS_V = WS_LF + 128 * MiB, WS_G = WS_V + 64 * MiB, WS_U = WS_G + 64 * MiB, WS_VG = WS_U + 64 * MiB,
                 WS_GB = WS_VG + 64 * MiB, WS_GA = WS_GB + 128 * MiB, WS_END = WS_GA + 128 * MiB;
constexpr size_t WS_HID = WS_PROJ;
constexpr size_t WS_MODP = WS_PROJ;
static_assert(WS_HID + (size_t)M * FF * 2 <= WS_END && WS_MOD + (size_t)DEPTH * BATCH * NMODC * 4 <= WS_LB, "d_ws map");
constexpr int CW_BAR = 4096;

constexpr int RING_OFF = 0, RING_BYTES = 131072;
constexpr int LDSCTL_OFF = RING_BYTES, MISC_OFF = LDSCTL_OFF + 320;
constexpr int LDS_BYTES = 147456;

#define GAS __attribute__((address_space(1)))
#define LAS __attribute__((address_space(3)))
typedef unsigned short bf16;
typedef unsigned v4u __attribute__((ext_vector_type(4)));
typedef unsigned v2u __attribute__((ext_vector_type(2)));
typedef float f32x4 __attribute__((ext_vector_type(4)));
typedef short bf16x8 __attribute__((ext_vector_type(8)));
typedef GAS unsigned gu32;
#define RLX_AGENT __ATOMIC_RELAXED, __HIP_MEMORY_SCOPE_AGENT
#define LDS_WAIT() asm volatile("s_waitcnt lgkmcnt(0)" ::: "memory")
#define VM_WAIT() asm volatile("s_waitcnt vmcnt(0)" ::: "memory")
__device__ __forceinline__ unsigned f2bf(float f) { return (unsigned)__builtin_bit_cast(unsigned short, (__bf16)f); }
__device__ __forceinline__ unsigned pk2(float lo, float hi) { return pg8::cvt_pk_bf16(lo, hi); }
__device__ __forceinline__ float bflo(unsigned w) { return __uint_as_float(w << 16); }
__device__ __forceinline__ float bfhi(unsigned w) { return __uint_as_float(w & 0xffff0000u); }
__device__ __forceinline__ float bf1(bf16 h) { return __uint_as_float(((unsigned)h) << 16); }
__device__ __forceinline__ float wave_sum(float v) {
#pragma unroll
    for (int o = 1; o < 64; o <<= 1) v += __shfl_xor(v, o);
    return v;
}

#define XB_TMO      128
#define XB_XCNT(j)  (256  + 64 * (j))
#define XB_XSUB(j)  (1280 + 64 * (j))
#define XB_XGEN(j)  (2304 + 64 * (j))
#define XB_TOP      3328
#define XB_TOPGEN   3392
#define XCD_BAR_WORDS 3456
#define XB_SPIN_CAP (1u << 18)

__device__ __forceinline__ unsigned xb_ld(unsigned* p)              { return __hip_atomic_load(p, __ATOMIC_RELAXED, __HIP_MEMORY_SCOPE_AGENT); }
__device__ __forceinline__ unsigned xb_add(unsigned* p, unsigned v) { return __hip_atomic_fetch_add(p, v, __ATOMIC_RELAXED, __HIP_MEMORY_SCOPE_AGENT); }
__device__ __forceinline__ unsigned xb_xcc_id() { return (unsigned)__builtin_amdgcn_s_getreg((3 << 11) | 20) & 0xFu; }
#define XB_SPIN(cond, bar) do { unsigned _sp = 0; while (cond) { __builtin_amdgcn_s_sleep(1); \
    if ((++_sp & 255u) == 0u) { if (xb_ld(&(bar)[XB_TMO])) break; if (_sp > XB_SPIN_CAP) { atomicAdd(&(bar)[XB_TMO], 1u); break; } } } } while (0)

struct XcdBarrier {
    unsigned* bar; unsigned x;
    volatile LAS unsigned* st;
};

__device__ __forceinline__ XcdBarrier xcd_barrier_post(unsigned* bar, volatile LAS unsigned* st) {
    XcdBarrier b; b.bar = bar; b.x = xb_xcc_id(); b.st = st;
    if (threadIdx.x == 0) (void)xb_add(&bar[XB_XCNT(b.x)], 1u);
    return b;
}
__device__ __forceinline__ void xcd_barrier_complete(unsigned* bar, unsigned x, unsigned& nloc, unsigned& nx) {
    const unsigned G = gridDim.x * gridDim.y * gridDim.z;
    unsigned sum, cnt, mine, sp = 0u;
    for (;;) {
        sum = 0u; cnt = 0u; mine = 0u;
#pragma unroll
        for (unsigned j = 0; j < 16; ++j) { const unsigned c = xb_ld(&bar[XB_XCNT(j)]); sum += c; cnt += (c > 0u) ? 1u : 0u; mine = (j == x) ? c : mine; }
        if (sum == G) break;
        __builtin_amdgcn_s_sleep(1);
        if ((++sp & 255u) == 0u) { if (xb_ld(&bar[XB_TMO])) break; if (sp > XB_SPIN_CAP) { atomicAdd(&bar[XB_TMO], 1u); break; } }
    }
    nloc = mine > 0u ? mine : 1u; nx = cnt > 0u ? cnt : 1u;
}

__device__ __forceinline__ void xcd_barrier(const XcdBarrier& b) {
    asm volatile("s_waitcnt vmcnt(0)" ::: "memory");
    __syncthreads();
    if (threadIdx.x == 0) {
        unsigned* bar = b.bar;
        __builtin_amdgcn_s_waitcnt(0);
        unsigned nloc = b.st[0], nx = b.st[1];
        if (nloc == 0u) { xcd_barrier_complete(bar, b.x, nloc, nx); b.st[0] = nloc; b.st[1] = nx; }
        const unsigned old = xb_add(&bar[XB_XSUB(b.x)], 1u);
        const unsigned gen = old / nloc;
        if (old + 1u == (gen + 1u) * nloc) {
            __builtin_amdgcn_fence(__ATOMIC_RELEASE, "agent");
            asm volatile("s_waitcnt vmcnt(0)" ::: "memory");
            const unsigned og = xb_add(&bar[XB_TOP], 1u);
            const unsigned tg = og / nx;
            if (og + 1u == (tg + 1u) * nx) xb_add(&bar[XB_TOPGEN], 1u);
            else XB_SPIN(xb_ld(&bar[XB_TOPGEN]) == tg, bar);
            __builtin_amdgcn_fence(__ATOMIC_ACQUIRE, "agent");
            xb_add(&bar[XB_XGEN(b.x)], 1u);
            asm volatile("s_waitcnt vmcnt(0)" ::: "memory");
        } else {
            XB_SPIN(xb_ld(&bar[XB_XGEN(b.x)]) == gen, bar);
            __builtin_amdgcn_fence(__ATOMIC_ACQUIRE, "agent");
            asm volatile("s_waitcnt vmcnt(0)" ::: "memory");
        }
    }
    __syncthreads();
}

struct Frame {
    LAS unsigned char* lds;
    volatile LAS unsigned* MISC;
    gu32* ctl;
    int tid, lane, wave;
    int G, bid;
    unsigned char* ws;
    const float* const* in;
    float* out;
};

__device__ __forceinline__ void p0_transpose_item(const float* W, int K, int N, bf16* WT, LAS float* scr, int item, int lane) {
    const int nblk = N / 32, kb = item / nblk, nb = item % nblk, k0 = 64 * kb, n0 = 32 * nb;
#pragma unroll 8
    for (int i = 0; i < 32; ++i) { const int kk = 2 * i + (lane >> 5); scr[kk * 33 + (lane & 31)] = W[(size_t)(k0 + kk) * N + n0 + (lane & 31)]; }
    LDS_WAIT(); asm volatile("" ::: "memory");
    const int c = lane & 7;
#pragma unroll
    for (int j = 0; j < 4; ++j) { const int n = (lane >> 3) + 8 * j; const LAS float* s = scr + (8 * c) * 33 + n;
        v4u o; o.x = pk2(s[0 * 33], s[1 * 33]); o.y = pk2(s[2 * 33], s[3 * 33]); o.z = pk2(s[4 * 33], s[5 * 33]); o.w = pk2(s[6 * 33], s[7 * 33]);
        *(GAS v4u*)(WT + (size_t)(n0 + n) * K + k0 + 8 * c) = o; }
    LDS_WAIT(); asm volatile("" ::: "memory");
}
__device__ __forceinline__ void p0_mod_item(Frame& F, int item, LAS float* cT) {
    const int ks = item & 7, cb = (item >> 3) % 48, l = item / 384, k0 = 256 * ks, lane = F.lane;
    const float* c = F.in[1]; const float* W = F.in[2] + (size_t)l * D * NMODC;
    for (int idx = lane; idx < 4096; idx += 64) { const int kk = idx & 255, b = idx >> 8; const float x = c[b * D + k0 + kk]; cT[kk * 16 + b] = x * __builtin_amdgcn_rcpf(1.0f + __builtin_amdgcn_exp2f(-1.44269504089f * x)); }
    LDS_WAIT(); asm volatile("" ::: "memory");
    f32x4 acc[16];
#pragma unroll
    for (int b = 0; b < 16; ++b) acc[b] = (f32x4){0.f, 0.f, 0.f, 0.f};
    const float* wp = W + (size_t)k0 * NMODC + cb * 256 + 4 * lane;
#pragma unroll 4
    for (int kk = 0; kk < 256; ++kk) {
        const f32x4 w4 = *(const GAS f32x4*)(wp + (size_t)kk * NMODC);
        const LAS f32x4* cr = (const LAS f32x4*)(cT + kk * 16);
#pragma unroll
        for (int q = 0; q < 4; ++q) { const f32x4 cv = cr[q];
            acc[4 * q + 0] += w4 * cv.x; acc[4 * q + 1] += w4 * cv.y; acc[4 * q + 2] += w4 * cv.z; acc[4 * q + 3] += w4 * cv.w; }
    }
    float* o = (float*)(F.ws + WS_MODP) + ((size_t)(l * 8 + ks) * BATCH) * NMODC + cb * 256 + 4 * lane;
#pragma unroll
    for (int b = 0; b < 16; ++b) *(GAS f32x4*)(o + (size_t)b * NMODC) = acc[b];
    LDS_WAIT(); asm volatile("" ::: "memory");
}
__device__ __forceinline__ void p0a(Frame& F) {
    LAS float* scr = (LAS float*)(F.lds + RING_OFF + F.wave * 16384);
    const int gw = F.bid * NWAVES + F.wave, NGW = F.G * NWAVES;
    for (int it = gw; it < DEPTH * 48 * 8; it += NGW) p0_mod_item(F, it, scr);
    constexpr int I_IN = (D / 64) * (INW / 32), I_A = (AW / 64) * (D / 32), I_O = (D / 64) * (D / 32), I_F1 = (D / 64) * (FF / 32), I_F2 = (FF / 64) * (D / 32);
    constexpr int I_LAYER = I_IN + 2 * I_A + I_O + I_F1 + I_F2;
    for (int it = gw; it < DEPTH * I_LAYER; it += NGW) {
        const int l = it / I_LAYER; int r = it % I_LAYER; unsigned char* wl = F.ws + WS_W + (size_t)l * W_LAYER;
        if (r < I_IN) { p0_transpose_item(F.in[6] + (size_t)l * D * INW, D, INW, (bf16*)(wl + WO_IN), scr, r, F.lane); continue; } r -= I_IN;
        if (r < I_A) { p0_transpose_item(F.in[13] + (size_t)l * AW * D, AW, D, (bf16*)(wl + WO_A), scr, r, F.lane); continue; } r -= I_A;
        if (r < I_A) { p0_transpose_item(F.in[14] + (size_t)l * AW * D, AW, D, (bf16*)(wl + WO_B), scr, r, F.lane); continue; } r -= I_A;
        if (r < I_O) { p0_transpose_item(F.in[15] + (size_t)l * D * D, D, D, (bf16*)(wl + WO_OUT), scr, r, F.lane); continue; } r -= I_O;
        if (r < I_F1) { p0_transpose_item(F.in[16] + (size_t)l * D * FF, D, FF, (bf16*)(wl + WO_F1), scr, r, F.lane); continue; } r -= I_F1;
        p0_transpose_item(F.in[17] + (size_t)l * FF * D, FF, D, (bf16*)(wl + WO_F2), scr, r, F.lane);
    }
}
__device__ __forceinline__ void p0b(Frame& F) {
    const int gt = F.bid * (NWAVES * 64) + F.tid, NT = F.G * NWAVES * 64;
    const float* P = (const float*)(F.ws + WS_MODP); float* MOD = (float*)(F.ws + WS_MOD);
    for (int i = gt; i < DEPTH * BATCH * NMODC; i += NT) {
        const int j = i % NMODC, b = (i / NMODC) % BATCH, l = i / (NMODC * BATCH);
        float s = F.in[3][l * NMODC + j];
#pragma unroll
        for (int ks = 0; ks < 8; ++ks) s += P[((size_t)(l * 8 + ks) * BATCH + b) * NMODC + j];
        const int sec = j / D, col = j % D;
        if (sec == 1) s = F.in[4][l * D + col] * (1.0f + s);
        if (sec == 4) s = F.in[5][l * D + col] * (1.0f + s);
        MOD[i] = s;
    }
    float* LB = (float*)(F.ws + WS_LB);
    for (int k = gt; k < AW; k += NT) {
        float v[DEPTH], mx = -3.0e38f;
#pragma unroll
        for (int l = 0; l < DEPTH; ++l) { v[l] = F.in[7][l * AW + k]; mx = fmaxf(mx, v[l]); }
        float sum = 0.f;
#pragma unroll
        for (int l = 0; l < DEPTH; ++l) { v[l] = __expf(v[l] - mx); sum += v[l]; }
        const float inv = 1.0f / sum; float cum = 0.f;
#pragma unroll
        for (int l = 0; l < DEPTH; ++l) { cum += v[l] * inv; LB[l * AW + k] = cum - v[0] * inv; }
    }
}
__device__ __forceinline__ void norm_phase(Frame& F, const float* x, bf16* h, const float* sh, const float* a) {
    const int gw = F.bid * NWAVES + F.wave, NGW = F.G * NWAVES;
    for (int m = gw; m < M; m += NGW) {
        const GAS f32x4* xr = (const GAS f32x4*)(x + (size_t)m * D) + F.lane; const int b = m / SEQ;
        f32x4 v[8]; float s = 0.f;
#pragma unroll
        for (int j = 0; j < 8; ++j) { v[j] = xr[64 * j]; s += (v[j].x * v[j].x + v[j].y * v[j].y) + (v[j].z * v[j].z + v[j].w * v[j].w); }
        const float rstd = 1.0f / sqrtf(wave_sum(s) * (1.f / D) + EPS);
        const GAS f32x4* ar = (const GAS f32x4*)(a + (size_t)b * NMODC) + F.lane; const GAS f32x4* sr = (const GAS f32x4*)(sh + (size_t)b * NMODC) + F.lane;
        GAS v2u* o = (GAS v2u*)(h + (size_t)m * D) + F.lane;
#pragma unroll
        for (int j = 0; j < 8; ++j) { const f32x4 av = ar[64 * j], sv = sr[64 * j]; const f32x4 y = v[j] * rstd * av + sv; v2u w; w.x = pk2(y.x, y.y); w.y = pk2(y.z, y.w); o[64 * j] = w; }
    }
}
__device__ __forceinline__ void final_norm_phase(Frame& F, const float* x, float* out, const float* g) {
    const int gw = F.bid * NWAVES + F.wave, NGW = F.G * NWAVES;
    for (int m = gw; m < M; m += NGW) {
        const GAS f32x4* xr = (const GAS f32x4*)(x + (size_t)m * D) + F.lane;
        f32x4 v[8]; float s = 0.f;
#pragma unroll
        for (int j = 0; j < 8; ++j) { v[j] = xr[64 * j]; s += (v[j].x * v[j].x + v[j].y * v[j].y) + (v[j].z * v[j].z + v[j].w * v[j].w); }
        const float rstd = 1.0f / sqrtf(wave_sum(s) * (1.f / D) + EPS);
        const GAS f32x4* gr = (const GAS f32x4*)g + F.lane; GAS f32x4* o = (GAS f32x4*)(out + (size_t)m * D) + F.lane;
#pragma unroll
        for (int j = 0; j < 8; ++j) o[64 * j] = v[j] * rstd * gr[64 * j];
    }
}
__device__ __forceinline__ void hgrn_unit(Frame& F, int bh, const float* ng) {
    const int b = bh >> 3, h = bh & 7, tid = F.tid, v = tid & 127, kq = tid >> 7;
    LAS float* sq = (LAS float*)(F.lds + RING_OFF); LAS float* sk = sq + 4096; LAS float* sf = sk + 4096; LAS float* sv = sf + 4096; LAS float* po = sv + 4096;
    const bf16* Qb = (const bf16*)(F.ws + WS_Q); const bf16* Kb = (const bf16*)(F.ws + WS_K); const bf16* Vb = (const bf16*)(F.ws + WS_V); const bf16* Gb = (const bf16*)(F.ws + WS_G);
    const float* LF = (const float*)(F.ws + WS_LF); bf16* OG = (bf16*)(F.ws + WS_OG);
    float S[32];
#pragma unroll
    for (int j = 0; j < 32; ++j) S[j] = 0.f;
    const float ng0 = ng[F.lane], ng1 = ng[F.lane + 64];
    const int st = tid >> 4, sk0 = (tid & 15) * 8;
    for (int c = 0; c < SEQ / 32; ++c) {
        const size_t row0 = (size_t)b * SEQ + c * 32;
        { const size_t go = (row0 + st) * AW + h * 128 + sk0; const int lo = st * 128 + sk0;
          const v4u q8 = *(const GAS v4u*)(Qb + go), k8 = *(const GAS v4u*)(Kb + go), v8 = *(const GAS v4u*)(Vb + go);
          const f32x4 f0 = *(const GAS f32x4*)(LF + go), f1 = *(const GAS f32x4*)(LF + go + 4);
          *(LAS f32x4*)(sq + lo) = (f32x4){bflo(q8.x), bfhi(q8.x), bflo(q8.y), bfhi(q8.y)}; *(LAS f32x4*)(sq + lo + 4) = (f32x4){bflo(q8.z), bfhi(q8.z), bflo(q8.w), bfhi(q8.w)};
          *(LAS f32x4*)(sk + lo) = (f32x4){bflo(k8.x), bfhi(k8.x), bflo(k8.y), bfhi(k8.y)}; *(LAS f32x4*)(sk + lo + 4) = (f32x4){bflo(k8.z), bfhi(k8.z), bflo(k8.w), bfhi(k8.w)};
          *(LAS f32x4*)(sv + lo) = (f32x4){bflo(v8.x), bfhi(v8.x), bflo(v8.y), bfhi(v8.y)}; *(LAS f32x4*)(sv + lo + 4) = (f32x4){bflo(v8.z), bfhi(v8.z), bflo(v8.w), bfhi(v8.w)};
          *(LAS f32x4*)(sf + lo) = (f32x4){__expf(f0.x), __expf(f0.y), __expf(f0.z), __expf(f0.w)}; *(LAS f32x4*)(sf + lo + 4) = (f32x4){__expf(f1.x), __expf(f1.y), __expf(f1.z), __expf(f1.w)}; }
        __syncthreads();
        for (int t = 0; t < 32; ++t) {
            const float vt = sv[t * 128 + v]; float acc = 0.f;
            const LAS f32x4* fq4 = (const LAS f32x4*)(sf + t * 128 + kq * 32); const LAS f32x4* kq4 = (const LAS f32x4*)(sk + t * 128 + kq * 32); const LAS f32x4* qq4 = (const LAS f32x4*)(sq + t * 128 + kq * 32);
#pragma unroll
            for (int j4 = 0; j4 < 8; ++j4) { const f32x4 ff = fq4[j4], kk = kq4[j4], qq = qq4[j4];
                S[4 * j4 + 0] = fmaf(ff.x, S[4 * j4 + 0], kk.x * vt); acc = fmaf(S[4 * j4 + 0], qq.x, acc);
                S[4 * j4 + 1] = fmaf(ff.y, S[4 * j4 + 1], kk.y * vt); acc = fmaf(S[4 * j4 + 1], qq.y, acc);
                S[4 * j4 + 2] = fmaf(ff.z, S[4 * j4 + 2], kk.z * vt); acc = fmaf(S[4 * j4 + 2], qq.z, acc);
                S[4 * j4 + 3] = fmaf(ff.w, S[4 * j4 + 3], kk.w * vt); acc = fmaf(S[4 * j4 + 3], qq.w, acc); }
            po[(kq * 32 + t) * 128 + v] = acc;
        }
        __syncthreads();
#pragma unroll
        for (int tt = 0; tt < 4; ++tt) { const int t = 4 * F.wave + tt;
            float o0 = 0.f, o1 = 0.f;
#pragma unroll
            for (int q = 0; q < 4; ++q) { o0 += po[(q * 32 + t) * 128 + F.lane]; o1 += po[(q * 32 + t) * 128 + F.lane + 64]; }
            const float rstd = 1.0f / sqrtf(wave_sum(o0 * o0 + o1 * o1) * (1.f / 128.f) + EPS);
            const size_t go = (row0 + t) * AW + h * 128 + F.lane;
            OG[go] = (bf16)f2bf(o0 * rstd * ng0 * bf1(Gb[go])); OG[go + 64] = (bf16)f2bf(o1 * rstd * ng1 * bf1(Gb[go + 64])); }
    }
    __syncthreads();
}
constexpr int SG_PITCH = 136;
__device__ __forceinline__ void sgu_unit(Frame& F, int bn, const float* lng, const float* lnb, const float* wsp, const float* bsp) {
    const int tid = F.tid, lane = F.lane, wave = F.wave; const size_t r0 = (size_t)bn * 128;
    LAS bf16* VnT = (LAS bf16*)(F.lds + RING_OFF);
    LAS float* stat = (LAS float*)(F.lds + RING_OFF + 36864);
    const bf16* Vg = (const bf16*)(F.ws + WS_VG); const bf16* Ub = (const bf16*)(F.ws + WS_U); bf16* SG = (bf16*)(F.ws + WS_SG);
    __syncthreads();
    for (int i = 0; i < 16; ++i) { const int t = 16 * wave + i; const bf16* vr = Vg + (r0 + t) * AW;
        const v4u a = *(const GAS v4u*)(vr + 8 * lane), c = *(const GAS v4u*)(vr + 512 + 8 * lane);
        float x[16] = {bflo(a.x), bfhi(a.x), bflo(a.y), bfhi(a.y), bflo(a.z), bfhi(a.z), bflo(a.w), bfhi(a.w), bflo(c.x), bfhi(c.x), bflo(c.y), bfhi(c.y), bflo(c.z), bfhi(c.z), bflo(c.w), bfhi(c.w)};
        float s = 0.f;
#pragma unroll
        for (int j = 0; j < 16; ++j) s += x[j];
        const float mean = wave_sum(s) * (1.f / 1024.f); float q = 0.f;
#pragma unroll
        for (int j = 0; j < 16; ++j) { const float d = x[j] - mean; q += d * d; }
        const float rstd = 1.0f / sqrtf(wave_sum(q) * (1.f / 1024.f) + EPS);
        if (lane == 0) { stat[2 * t] = mean; stat[2 * t + 1] = rstd; } }
    __syncthreads();
    const int fr = lane & 15, fq = lane >> 4;
    for (int g = 0; g < 8; ++g) {
        { const int s = tid >> 2, dq = tid & 3; const float mean = stat[2 * s], rstd = stat[2 * s + 1];
#pragma unroll
          for (int i = 0; i < 4; ++i) { const int d0 = dq * 32 + 8 * i; const v4u a = *(const GAS v4u*)(Vg + (r0 + s) * AW + g * 128 + d0);
              const f32x4 g0 = *(const GAS f32x4*)(lng + g * 128 + d0), g1 = *(const GAS f32x4*)(lng + g * 128 + d0 + 4), b0 = *(const GAS f32x4*)(lnb + g * 128 + d0), b1 = *(const GAS f32x4*)(lnb + g * 128 + d0 + 4);
              const float x[8] = {bflo(a.x), bfhi(a.x), bflo(a.y), bfhi(a.y), bflo(a.z), bfhi(a.z), bflo(a.w), bfhi(a.w)};
              const float gg[8] = {g0.x, g0.y, g0.z, g0.w, g1.x, g1.y, g1.z, g1.w}, bb[8] = {b0.x, b0.y, b0.z, b0.w, b1.x, b1.y, b1.z, b1.w};
#pragma unroll
              for (int j = 0; j < 8; ++j) VnT[(d0 + j) * SG_PITCH + s] = (bf16)f2bf((x[j] - mean) * rstd * gg[j] + bb[j]); } }
        __syncthreads();
        f32x4 acc[8];
#pragma unroll
        for (int nt = 0; nt < 8; ++nt) acc[nt] = (f32x4){0.f, 0.f, 0.f, 0.f};
        const int t = 16 * wave + fr; const float* wr_ = wsp + ((size_t)g * 128 + t) * 128;
#pragma unroll
        for (int ks = 0; ks < 4; ++ks) { const int s0 = 32 * ks + 8 * fq;
            const f32x4 w0 = *(const GAS f32x4*)(wr_ + s0), w1 = *(const GAS f32x4*)(wr_ + s0 + 4);
            const float wv[8] = {w0.x, w0.y, w0.z, w0.w, w1.x, w1.y, w1.z, w1.w}; bf16x8 A;
#pragma unroll
            for (int j = 0; j < 8; ++j) A[j] = (short)f2bf((s0 + j <= t) ? wv[j] : 0.f);
#pragma unroll
            for (int nt = 0; nt < 8; ++nt) { const bf16x8 B = *(const LAS bf16x8*)(VnT + (16 * nt + fr) * SG_PITCH + s0);
                acc[nt] = __builtin_amdgcn_mfma_f32_16x16x32_bf16(A, B, acc[nt], 0, 0, 0); } }
#pragma unroll
        for (int i = 0; i < 4; ++i) { const int to = 16 * wave + 4 * fq + i; const float bs = bsp[g * 128 + to];
#pragma unroll
            for (int nt = 0; nt < 8; ++nt) { const size_t go = (r0 + to) * AW + g * 128 + 16 * nt + fr; SG[go] = (bf16)f2bf((acc[nt][i] + bs) * bf1(Ub[go])); } }
        __syncthreads();
    }
}

struct Args { const float* in[19]; float* out; unsigned char* ws; int ph_lo, ph_hi; };
__global__ void __launch_bounds__(NWAVES * 64, 2) hybrid_fwd(Args args) {
    extern __shared__ __attribute__((aligned(16))) unsigned char lds[];
    Frame F;
    F.lds = (LAS unsigned char*)lds;
    F.MISC = (volatile LAS unsigned*)(F.lds + MISC_OFF);
    F.tid = threadIdx.x; F.lane = F.tid & 63; F.wave = __builtin_amdgcn_readfirstlane(F.tid >> 6);
    F.G = gridDim.x; F.bid = blockIdx.x;
    F.ws = args.ws; F.ctl = (gu32*)(args.ws + WS_CTL); F.out = args.out;
    F.in = args.in;
    for (int u = F.tid; u < (LDS_BYTES - LDSCTL_OFF) / 4; u += NWAVES * 64) ((LAS unsigned*)(F.lds + LDSCTL_OFF))[u] = 0u;
    __syncthreads();
    const int lo = args.ph_lo, hi = args.ph_hi;
    XcdBarrier bar; bar.bar = (unsigned*)(F.ctl + CW_BAR); bar.x = 0; bar.st = nullptr;
#ifdef DBG_STOP
    bar = xcd_barrier_post((unsigned*)(F.ctl + CW_BAR), F.MISC + 8);
#else
    if (hi - lo > 1) bar = xcd_barrier_post((unsigned*)(F.ctl + CW_BAR), F.MISC + 8);
#endif
#ifndef PH_MASK
#define PH_MASK 0xFFF
#endif
#define PHON(j) ((PH_MASK >> (j)) & 1)
#define IN(k) (lo <= (k) && (k) < hi)
#define FRESH() do { int t_ = threadIdx.x; asm volatile("" : "+v"(t_)); F.tid = t_; F.lane = t_ & 63; } while (0)
#define SEAM(k) do { if (IN(k) && IN((k) + 1)) xcd_barrier(bar); } while (0)
    bf16* ACT = (bf16*)(F.ws + WS_ACT); bf16* OG = (bf16*)(F.ws + WS_OG); bf16* SG = (bf16*)(F.ws + WS_SG); bf16* HID = (bf16*)(F.ws + WS_HID);
    const float* MOD = (const float*)(F.ws + WS_MOD);

    if (PHON(0) && IN(0)) { FRESH(); p0a(F); SEAM(0); }
    if (PHON(1) && IN(1)) { FRESH(); p0b(F); SEAM(1); }
    for (int l = 0; l < DEPTH; ++l) {
        const int pb = 2 + 9 * l;
        const float* MODl = MOD + (size_t)l * BATCH * NMODC;
        const unsigned char* wl = F.ws + WS_W + (size_t)l * W_LAYER;
        const float* xin = (l == 0) ? F.in[0] : (const float*)F.out;
        if (PHON(2) && IN(pb + 0)) { FRESH(); norm_phase(F, xin, ACT, MODl + 0 * D, MODl + 1 * D); SEAM(pb + 0); }
        if (PHON(3) && IN(pb + 1)) {
            pg8::Gemm g{ACT, (const bf16*)(wl + WO_IN), M, INW, D}; pg8::StaticOrder S; S.init(M, INW, F.G, F.bid);
            pg8::EpiProj E{(bf16*)(F.ws + WS_Q), (bf16*)(F.ws + WS_K), (bf16*)(F.ws + WS_V), (bf16*)(F.ws + WS_G), (bf16*)(F.ws + WS_U), (bf16*)(F.ws + WS_VG), (bf16*)(F.ws + WS_GA), (bf16*)(F.ws + WS_GB),
                           (float*)(F.ws + WS_LF), (const float*)(F.ws + WS_LB) + l * AW};
            pg8::gemm_phase<pg8::EpiProj, pg8::StaticOrder, true, true>(F.lds + RING_OFF, g, S, E);
            SEAM(pb + 1);
        }
        if (PHON(4) && IN(pb + 2)) {
            FRESH();
            const float* ng = F.in[8] + l * 128; const float* lng = F.in[9] + l * AW; const float* lnb = F.in[10] + l * AW;
            const float* wsp = F.in[11] + (size_t)l * 8 * 128 * 128; const float* bsp = F.in[12] + l * 8 * 128;
            for (int i = 0;; ++i) {
                int u;
                if (F.G == 256) { if (F.bid < 128) { if (i > 0) break; u = F.bid; } else { if (i > 1) break; u = 128 + 2 * (F.bid - 128) + i; } }
                else { u = F.bid + i * F.G; if (u >= 128 + 256) break; }
                if (u < 128) hgrn_unit(F, u, ng); else sgu_unit(F, u - 128, lng, lnb, wsp, bsp);
            }
            SEAM(pb + 2);
        }
        if (PHON(5) && IN(pb + 3)) {
            pg8::Gemm g{OG, (const bf16*)(wl + WO_A), M, D, AW}; pg8::StaticOrder S; S.init(M, D, F.G, F.bid);
            pg8::EpiMerge<false> E{(const bf16*)(F.ws + WS_GA), ACT};
            pg8::gemm_phase<pg8::EpiMerge<false>, pg8::StaticOrder, true, true>(F.lds + RING_OFF, g, S, E);
            SEAM(pb + 3);
        }
        if (PHON(6) && IN(pb + 4)) {
            pg8::Gemm g{SG, (const bf16*)(wl + WO_B), M, D, AW}; pg8::StaticOrder S; S.init(M, D, F.G, F.bid);
            pg8::EpiMerge<true> E{(const bf16*)(F.ws + WS_GB), ACT};
            pg8::gemm_phase<pg8::EpiMerge<true>, pg8::StaticOrder, true, true>(F.lds + RING_OFF, g, S, E);
            SEAM(pb + 4);
        }
        if (PHON(7) && IN(pb + 5)) {
            pg8::Gemm g{ACT, (const bf16*)(wl + WO_OUT), M, D, D}; pg8::StaticOrder S; S.init(M, D, F.G, F.bid);
            pg8::EpiResid E{xin, F.out, MODl + 2 * D};
            pg8::gemm_phase<pg8::EpiResid, pg8::StaticOrder, true, true>(F.lds + RING_OFF, g, S, E);
            SEAM(pb + 5);
        }
        if (PHON(8) && IN(pb + 6)) { FRESH(); norm_phase(F, F.out, ACT, MODl + 3 * D, MODl + 4 * D); SEAM(pb + 6); }
        if (PHON(9) && IN(pb + 7)) {
            pg8::Gemm g{ACT, (const bf16*)(wl + WO_F1), M, FF, D}; pg8::StaticOrder S; S.init(M, FF, F.G, F.bid);
            pg8::EpiRelu2 E{HID};
            pg8::gemm_phase<pg8::EpiRelu2, pg8::StaticOrder, true, true>(F.lds + RING_OFF, g, S, E);
            SEAM(pb + 7);
        }
        if (PHON(10) && IN(pb + 8)) {
            pg8::Gemm g{HID, (const bf16*)(wl + WO_F2), M, D, FF}; pg8::StaticOrder S; S.init(M, D, F.G, F.bid);
            pg8::EpiResid E{F.out, F.out, MODl + 5 * D};
            pg8::gemm_phase<pg8::EpiResid, pg8::StaticOrder, true, true>(F.lds + RING_OFF, g, S, E);
            SEAM(pb + 8);
        }
    }
    if (PHON(11) && IN(N_PHASES - 1)) { FRESH(); final_norm_phase(F, F.out, F.out, F.in[18]); }
#ifdef DBG_STOP
    xcd_barrier(bar);
    if (DBG_BUF >= 0) { FRESH(); const bf16* src = (const bf16*)(F.ws + (size_t)DBG_BUF * MiB); const size_t n = (size_t)M * D, NT = (size_t)F.G * NWAVES * 64;
      for (size_t i = (size_t)F.bid * (NWAVES * 64) + F.tid; i < n; i += NT) F.out[i] = DBG_F32 ? ((const float*)src)[i] : bf1(src[i]); }
#endif
#undef IN
#undef SEAM
}

extern "C" void kernel_launch(void* const* d_in, const int* in_sizes, int n_in, void* d_out, int out_size, void* d_ws, size_t ws_size, hipStream_t stream) {
    static int grid = 0;
    if (grid == 0) {
        if (n_in != 19 || in_sizes[0] != M * D || out_size != M * D || ws_size < WS_END) { fprintf(stderr, "kernel_launch: unexpected shapes: n_in %d in0 %d out %d ws %zu (need %zu)\n", n_in, n_in > 0 ? in_sizes[0] : -1, out_size, ws_size, (size_t)WS_END); grid = -1; return; }
        int dev = 0, cus = 0, per_cu = 0;
        if (hipGetDevice(&dev) != hipSuccess || hipDeviceGetAttribute(&cus, hipDeviceAttributeMultiprocessorCount, dev) != hipSuccess) { grid = -1; return; }
        if (hipFuncSetAttribute((const void*)hybrid_fwd, hipFuncAttributeMaxDynamicSharedMemorySize, LDS_BYTES) != hipSuccess) { fprintf(stderr, "kernel_launch: hipFuncSetAttribute failed\n"); grid = -1; return; }
        if (hipOccupancyMaxActiveBlocksPerMultiprocessor(&per_cu, (const void*)hybrid_fwd, NWAVES * 64, LDS_BYTES) != hipSuccess || per_cu < 1) fprintf(stderr, "kernel_launch: occupancy query reports %d\n", per_cu);
        (void)hipGetLastError();
        grid = cus;
    }
    if (grid < 0) return;
    if (hipMemsetAsync((char*)d_ws + WS_CTL, 0, CTL_ZERO_BYTES, stream) != hipSuccess) return;
    Args a{};
    for (int i = 0; i < 19; ++i) a.in[i] = (const float*)d_in[i];
    a.out = (float*)d_out; a.ws = (unsigned char*)d_ws;
#if MK_SINGLE
#ifdef DBG_STOP
    a.ph_lo = 0; a.ph_hi = DBG_STOP;
#else
    a.ph_lo = 0; a.ph_hi = N_PHASES;
#endif
    hipLaunchKernelGGL(hybrid_fwd, dim3(grid), dim3(NWAVES * 64), LDS_BYTES, stream, a);
#else
    for (int k = 0; k < N_PHASES; ++k) { a.ph_lo = k; a.ph_hi = k + 1; hipLaunchKernelGGL(hybrid_fwd, dim3(grid), dim3(NWAVES * 64), LDS_BYTES, stream, a); }
#endif
}
```

```cpp
#include <hip/hip_runtime.h>
#include <cstdio>
#include <cstdint>
namespace pg8 {
#define PG8_LAS __attribute__((address_space(3)))
typedef unsigned short bf16_t;
typedef short bf16x8 __attribute__((ext_vector_type(8)));
typedef float f32x4 __attribute__((ext_vector_type(4)));
typedef unsigned u32x4 __attribute__((ext_vector_type(4)));
constexpr int BM = 256, BK = 64, HALF = 128, HTB = HALF * BK * 2  , STAGE_BYTES = 8 * HTB, NXCD = 8, WGM = 8;

__host__ __device__ __forceinline__ int lds_byte(int r, int c) { const int st = (r >> 4) * 2 + (c >> 5), rr = r & 15, cc = c & 31, ob = rr * 64 + cc * 2; return st * 1024 + (ob ^ (((ob >> 9) & 1) << 5)); }
__host__ __device__ __forceinline__ void stage_rc(int b, int& R, int& C) { const int st = b / 1024, sb = b % 1024, swz = sb ^ (((sb >> 9) & 1) << 5); R = (st >> 1) * 16 + swz / 64; C = (st & 1) * 32 + (swz % 64) / 2; }
__host__ __device__ __forceinline__ int perm32(int rho) { const int n = rho >> 4, i = rho & 15; return 8 * (i >> 2) + 4 * n + (i & 3); }

struct Unit { int pm, pn; };
struct Gemm { const bf16_t* A; const bf16_t* Bt; int M, N, K; };

struct StaticOrder {
    int nM, nN, nwg, G, c;
    __host__ __device__ void init(int M, int N, int G_, int c_) { nM = M / BM; nN = N / BM; nwg = nM * nN; G = G_; c = c_; }
    __host__ __device__ bool next(int i, Unit& u) const {
        const long L = (long)i * G + c; if (L >= nwg) return false;
        int wgid = (int)L; { const int q = nwg / NXCD, r = nwg % NXCD, xcd = wgid % NXCD, off = wgid / NXCD; wgid = (xcd < r ? xcd * (q + 1) : r * (q + 1) + (xcd - r) * q) + off; }
        const int nig = WGM * nN, gid = wgid / nig, fm = gid * WGM, gsz = (nM - fm) < WGM ? (nM - fm) : WGM;
        u.pm = fm + ((wgid % nig) % gsz); u.pn = (wgid % nig) / gsz; return true;
    }
    __device__ __forceinline__ void a_ready(const Unit&) const {}
    __device__ __forceinline__ void done(const Unit&) const {}
};
typedef float f32x2 __attribute__((ext_vector_type(2)));
typedef __bf16 bf16x2_t __attribute__((ext_vector_type(2)));
__device__ __forceinline__ unsigned cvt_pk_bf16(float lo, float hi) { const f32x2 v = {lo, hi}; return __builtin_bit_cast(unsigned, __builtin_convertvector(v, bf16x2_t)); }
__device__ __forceinline__ f32x2 gelu_pk(f32x2 v) {
    const f32x2 av = __builtin_elementwise_abs(v), d = av * 0.2316418882f + 1.0f;
    f32x2 t; t.x = __builtin_amdgcn_rcpf(d.x); t.y = __builtin_amdgcn_rcpf(d.y);
    f32x2 q = t * 0.5307027145f + (-0.7265760135f); q = q * t + 0.7107068705f; q = q * t + (-0.142248368f); q = q * t + 0.127414796f; q = q * t;
    const f32x2 s = (v * v) * (-0.72134752044f);
    f32x2 e; e.x = __builtin_amdgcn_exp2f(s.x); e.y = __builtin_amdgcn_exp2f(s.y);
    const f32x2 m = v * (q * e), r = v - m;
    f32x2 o; o.x = v.x < 0.f ? m.x : r.x; o.y = v.y < 0.f ? m.y : r.y; return o;
}

__device__ __forceinline__ float fsigmoid(float x) { return __builtin_amdgcn_rcpf(1.0f + __builtin_amdgcn_exp2f(-1.44269504089f * x)); }
__device__ __forceinline__ float bf_lo(unsigned w) { return __uint_as_float(w << 16); }
__device__ __forceinline__ float bf_hi(unsigned w) { return __uint_as_float(w & 0xffff0000u); }
template <int ACT> __device__ __forceinline__ void act8(f32x4& v0, f32x4& v1) {
    if (ACT == 1) {
#pragma unroll
        for (int j = 0; j < 4; ++j) { v0[j] = v0[j] * fsigmoid(v0[j]); v1[j] = v1[j] * fsigmoid(v1[j]); } }
    if (ACT == 2) { f32x2 a = gelu_pk((f32x2){v0[0], v0[1]}), b = gelu_pk((f32x2){v0[2], v0[3]}), c = gelu_pk((f32x2){v1[0], v1[1]}), d = gelu_pk((f32x2){v1[2], v1[3]});
        v0 = (f32x4){a.x, a.y, b.x, b.y}; v1 = (f32x4){c.x, c.y, d.x, d.y}; }
    if (ACT == 3) {
#pragma unroll
        for (int j = 0; j < 4; ++j) { v0[j] = fsigmoid(v0[j]); v1[j] = fsigmoid(v1[j]); } }
    if (ACT == 4) {
#pragma unroll
        for (int j = 0; j < 4; ++j) { const float a = fmaxf(v0[j], 0.f), b = fmaxf(v1[j], 0.f); v0[j] = a * a; v1[j] = b * b; } }
}
template <int ACT> __device__ __forceinline__ void store_act(const f32x4 (&acc)[2][2][4][2], bf16_t* dst, int ldc, int row0, int col0) {
#pragma unroll
    for (int ai = 0; ai < 2; ++ai)
#pragma unroll
        for (int m = 0; m < 4; ++m) { bf16_t* rowp = dst + (size_t)(row0 + ai * HALF + m * 16) * ldc + col0;
#pragma unroll
            for (int bj = 0; bj < 2; ++bj) { f32x4 v0 = acc[ai][bj][m][0], v1 = acc[ai][bj][m][1];
                act8<ACT>(v0, v1);
                u32x4 w; w.x = cvt_pk_bf16(v0[0], v0[1]); w.y = cvt_pk_bf16(v0[2], v0[3]); w.z = cvt_pk_bf16(v1[0], v1[1]); w.w = cvt_pk_bf16(v1[2], v1[3]);
                *(u32x4*)(rowp + bj * HALF) = w; } }
}
struct EpiProj {
    static constexpr bool PERM = true, AFTER_DRAIN = false;
    bf16_t *Qb, *Kb, *Vb, *Gb, *Ub, *Vgb, *GA, *GB; float* LF; const float* lb;
    __device__ __forceinline__ void operator()(const f32x4 (&acc)[2][2][4][2], const Unit& u, int wr, int wc, int fr, int fq) const {
        const int seg = u.pn >> 2, row0 = u.pm * BM + wr * 64 + fr, cw = wc * 32 + 8 * fq, c4 = (u.pn & 3) * BM + cw;
        if (seg == 1) {
            f32x4 l0[2], l1[2];
#pragma unroll
            for (int bj = 0; bj < 2; ++bj) { l0[bj] = *(const f32x4*)(lb + c4 + bj * HALF); l1[bj] = *(const f32x4*)(lb + c4 + bj * HALF + 4); }
#pragma unroll
            for (int ai = 0; ai < 2; ++ai)
#pragma unroll
                for (int m = 0; m < 4; ++m) { const size_t ro = (size_t)(row0 + ai * HALF + m * 16) * 1024 + c4;
#pragma unroll
                    for (int bj = 0; bj < 2; ++bj) { f32x4 v0 = acc[ai][bj][m][0], v1 = acc[ai][bj][m][1], g0, g1;
#pragma unroll
                        for (int j = 0; j < 4; ++j) {
                            { const float x = fminf(fmaxf(v0[j], -80.f), 80.f), e = __builtin_amdgcn_exp2f(-1.44269504089f * x), s = __builtin_amdgcn_rcpf(1.0f + e), lbv = l0[bj][j], om = 1.0f - lbv;
                              g0[j] = 0.69314718056f * __builtin_amdgcn_logf(fmaxf(lbv + om * s, 1e-20f)); v0[j] = om * (e * s); }
                            { const float x = fminf(fmaxf(v1[j], -80.f), 80.f), e = __builtin_amdgcn_exp2f(-1.44269504089f * x), s = __builtin_amdgcn_rcpf(1.0f + e), lbv = l1[bj][j], om = 1.0f - lbv;
                              g1[j] = 0.69314718056f * __builtin_amdgcn_logf(fmaxf(lbv + om * s, 1e-20f)); v1[j] = om * (e * s); } }
                        u32x4 w; w.x = cvt_pk_bf16(v0[0], v0[1]); w.y = cvt_pk_bf16(v0[2], v0[3]); w.z = cvt_pk_bf16(v1[0], v1[1]); w.w = cvt_pk_bf16(v1[2], v1[3]);
                        *(u32x4*)(Kb + ro + bj * HALF) = w; *(f32x4*)(LF + ro + bj * HALF) = g0; *(f32x4*)(LF + ro + bj * HALF + 4) = g1; } }
            return;
        }
        if (seg == 0) store_act<1>(acc, Qb, 1024, row0, c4);
        else if (seg == 2) store_act<0>(acc, Vb, 1024, row0, c4);
        else if (seg == 3) store_act<1>(acc, Gb, 1024, row0, c4);
        else if (seg == 4) store_act<2>(acc, Ub, 1024, row0, c4);
        else if (seg == 5) store_act<2>(acc, Vgb, 1024, row0, c4);
        else if (seg < 8) store_act<3>(acc, GA, 2048, row0, (u.pn - 24) * BM + cw);
        else store_act<3>(acc, GB, 2048, row0, (u.pn - 32) * BM + cw);
    }
};
template <bool ADD> struct EpiMerge {
    static constexpr bool PERM = true, AFTER_DRAIN = false;
    const bf16_t* gate; bf16_t* out;
    __device__ __forceinline__ void operator()(const f32x4 (&acc)[2][2][4][2], const Unit& u, int wr, int wc, int fr, int fq) const {
        const int row0 = u.pm * BM + wr * 64 + fr, col0 = u.pn * BM + wc * 32 + 8 * fq;
        constexpr int MB = ADD ? 2 : 4;
#pragma unroll
        for (int ai = 0; ai < 2; ++ai)
#pragma unroll
          for (int mb = 0; mb < 4; mb += MB) {
            u32x4 g[MB][2], o[MB][2];
#pragma unroll
            for (int m = 0; m < MB; ++m)
#pragma unroll
                for (int bj = 0; bj < 2; ++bj) { const size_t ro = (size_t)(row0 + ai * HALF + (mb + m) * 16) * 2048 + col0 + bj * HALF;
                    g[m][bj] = *(const u32x4*)(gate + ro); if (ADD) o[m][bj] = *(const u32x4*)(out + ro); }
            asm volatile("" ::: "memory");
#pragma unroll
            for (int m = 0; m < MB; ++m)
#pragma unroll
                for (int bj = 0; bj < 2; ++bj) { const size_t ro = (size_t)(row0 + ai * HALF + (mb + m) * 16) * 2048 + col0 + bj * HALF;
                    f32x4 v0 = acc[ai][bj][mb + m][0], v1 = acc[ai][bj][mb + m][1]; const u32x4 gg = g[m][bj];
                    v0[0] *= bf_lo(gg.x); v0[1] *= bf_hi(gg.x); v0[2] *= bf_lo(gg.y); v0[3] *= bf_hi(gg.y); v1[0] *= bf_lo(gg.z); v1[1] *= bf_hi(gg.z); v1[2] *= bf_lo(gg.w); v1[3] *= bf_hi(gg.w);
                    if (ADD) { const u32x4 oo = o[m][bj];
                        v0[0] += bf_lo(oo.x); v0[1] += bf_hi(oo.x); v0[2] += bf_lo(oo.y); v0[3] += bf_hi(oo.y); v1[0] += bf_lo(oo.z); v1[1] += bf_hi(oo.z); v1[2] += bf_lo(oo.w); v1[3] += bf_hi(oo.w); }
                    u32x4 w; w.x = cvt_pk_bf16(v0[0], v0[1]); w.y = cvt_pk_bf16(v0[2], v0[3]); w.z = cvt_pk_bf16(v1[0], v1[1]); w.w = cvt_pk_bf16(v1[2], v1[3]);
                    *(u32x4*)(out + ro) = w; }
            asm volatile("" ::: "memory");
          }
    }
};
struct EpiResid {
    static constexpr bool PERM = false, AFTER_DRAIN = false;
    const float* xin; float* xout; const float* gt;
    __device__ __forceinline__ void operator()(const f32x4 (&acc)[2][2][4][2], const Unit& u, int wr, int wc, int fr, int fq) const {
        const int row0 = u.pm * BM + wr * 64 + fr, col0 = u.pn * BM + wc * 32 + 4 * fq, b = u.pm >> 3;
        f32x4 gv[2][2];
#pragma unroll
        for (int bj = 0; bj < 2; ++bj)
#pragma unroll
            for (int n = 0; n < 2; ++n) gv[bj][n] = *(const f32x4*)(gt + (size_t)b * 12288 + col0 + bj * HALF + n * 16);
#pragma unroll
        for (int ai = 0; ai < 2; ++ai)
#pragma unroll
          for (int mb = 0; mb < 4; mb += 2) {
            f32x4 xv[2][2][2];
#pragma unroll
            for (int m = 0; m < 2; ++m)
#pragma unroll
                for (int bj = 0; bj < 2; ++bj)
#pragma unroll
                    for (int n = 0; n < 2; ++n) xv[m][bj][n] = *(const f32x4*)(xin + (size_t)(row0 + ai * HALF + (mb + m) * 16) * 2048 + col0 + bj * HALF + n * 16);
            asm volatile("" ::: "memory");
#pragma unroll
            for (int m = 0; m < 2; ++m)
#pragma unroll
                for (int bj = 0; bj < 2; ++bj)
#pragma unroll
                    for (int n = 0; n < 2; ++n) *(f32x4*)(xout + (size_t)(row0 + ai * HALF + (mb + m) * 16) * 2048 + col0 + bj * HALF + n * 16) = xv[m][bj][n] + gv[bj][n] * acc[ai][bj][mb + m][n];
            asm volatile("" ::: "memory");
          }
    }
};
struct EpiRelu2 {
    static constexpr bool PERM = true, AFTER_DRAIN = false;
    bf16_t* out;
    __device__ __forceinline__ void operator()(const f32x4 (&acc)[2][2][4][2], const Unit& u, int wr, int wc, int fr, int fq) const {
        store_act<4>(acc, out, 8192, u.pm * BM + wr * 64 + fr, u.pn * BM + wc * 32 + 8 * fq);
    }
};

template <class Epi, class Sched, bool ALIGN_EPI = false, bool SP2 = false>
__device__ __forceinline__ void gemm_phase(PG8_LAS unsigned char* lds, const Gemm g, const Sched& S, const Epi& E) {
    int tid_ = threadIdx.x; asm volatile("" : "+v"(tid_));
    const int tid = tid_, wid = __builtin_amdgcn_readfirstlane(tid >> 6), lane = tid & 63, wr = wid >> 2, wc = wid & 3, fr = lane & 15, fq = lane >> 4;
    const int K = g.K, nt = K / BK;
    unsigned voffA[2], voffB[2];
#pragma unroll
    for (int i = 0; i < 2; ++i) { int R, C; stage_rc(tid * 16 + i * 8192, R, C); const int Rb = Epi::PERM ? ((R & ~31) + perm32(R & 31)) : R;
        voffA[i] = (unsigned)(R * K + C) * 2u; voffB[i] = (unsigned)(Rb * K + C) * 2u; }
    const size_t kstep = (size_t)(BK * 2);
    const size_t hstep = (size_t)HALF * K * 2;
    const size_t tstep = 2 * hstep;
    const unsigned ldsw = (unsigned)wid * 1024u;
    const int aoff = lds_byte(wr * 64 + fr, fq * 8), boff = lds_byte(wc * 32 + fr, fq * 8);
#define PG8_SA(b, h) (((b) * 2 + (h)) * HTB)
#define PG8_SB(b, h) ((4 + (b) * 2 + (h)) * HTB)
#define PG8_STAGE(bufoff, gbase, voff) do { _Pragma("unroll") for (int _i = 0; _i < 2; ++_i) \
        __builtin_amdgcn_global_load_lds((const unsigned*)((const char*)(gbase) + (voff)[_i]), (PG8_LAS unsigned*)(lds + (bufoff) + ldsw + _i * 8192), 16, 0, 0); } while (0)
#define PG8_LDA(dst, b, h) do { _Pragma("unroll") for (int m = 0; m < 4; ++m) _Pragma("unroll") for (int k = 0; k < 2; ++k) dst[m][k] = *(const PG8_LAS bf16x8*)(lds + PG8_SA(b, h) + aoff + m * 2048 + k * 1024); } while (0)
#define PG8_LDB(dst, b, h) do { _Pragma("unroll") for (int n = 0; n < 2; ++n) _Pragma("unroll") for (int k = 0; k < 2; ++k) dst[n][k] = *(const PG8_LAS bf16x8*)(lds + PG8_SB(b, h) + boff + n * 2048 + k * 1024); } while (0)
#define PG8_MMA(ai, bj, At, Bt) do { __builtin_amdgcn_s_setprio(1); _Pragma("unroll") for (int m = 0; m < 4; ++m) _Pragma("unroll") for (int n = 0; n < 2; ++n) _Pragma("unroll") for (int k = 0; k < 2; ++k) \
        acc[ai][bj][m][n] = __builtin_amdgcn_mfma_f32_16x16x32_bf16(Bt[n][k], At[m][k], acc[ai][bj][m][n], 0, 0, 0); __builtin_amdgcn_s_setprio(0); } while (0)
#define PG8_WAIT_V(n) asm volatile("s_waitcnt vmcnt(" #n ")" ::: "memory")
#define PG8_WAIT_L(n) asm volatile("s_waitcnt lgkmcnt(" #n ")" ::: "memory")
#define PG8_BAR __builtin_amdgcn_s_barrier()
#define PG8_SCHED __builtin_amdgcn_sched_barrier(0)
    Unit cur, nxt; int ui = 0;
    if (!S.next(0, cur)) return;
    f32x4 acc[2][2][4][2];
#pragma unroll
    for (int a = 0; a < 2; ++a)
#pragma unroll
        for (int b = 0; b < 2; ++b)
#pragma unroll
            for (int m = 0; m < 4; ++m)
#pragma unroll
                for (int n = 0; n < 2; ++n) acc[a][b][m][n] = (f32x4){0.f, 0.f, 0.f, 0.f};
    bf16x8 At[4][2], B0[2][2], B1[2][2];
    const char* cA = (const char*)g.A + (size_t)cur.pm * tstep; const char* cB = (const char*)g.Bt + (size_t)cur.pn * tstep;
    S.a_ready(cur);
    if constexpr (SP2) {
        PG8_STAGE(PG8_SB(0, 0), cB, voffB); PG8_STAGE(PG8_SB(0, 1), cB + hstep, voffB); PG8_STAGE(PG8_SA(0, 0), cA, voffA); PG8_STAGE(PG8_SA(0, 1), cA + hstep, voffA);
        if (wr == 1) PG8_BAR;
        PG8_WAIT_V(2); PG8_BAR;
        PG8_STAGE(PG8_SB(1, 0), cB + kstep, voffB); PG8_STAGE(PG8_SA(1, 0), cA + kstep, voffA); PG8_STAGE(PG8_SB(1, 1), cB + hstep + kstep, voffB);
        PG8_WAIT_V(6); PG8_BAR;
    } else {
        PG8_STAGE(PG8_SB(0, 0), cB, voffB); PG8_STAGE(PG8_SA(0, 0), cA, voffA); PG8_STAGE(PG8_SB(0, 1), cB + hstep, voffB); PG8_STAGE(PG8_SA(0, 1), cA + hstep, voffA);
        if (wr == 1) PG8_BAR;
        PG8_WAIT_V(4); PG8_BAR;
        PG8_STAGE(PG8_SB(1, 0), cB + kstep, voffB); PG8_STAGE(PG8_SA(1, 0), cA + kstep, voffA); PG8_STAGE(PG8_SB(1, 1), cB + hstep + kstep, voffB);
        PG8_WAIT_V(6); PG8_BAR;
    }
    for (;;) {
        const bool has_next = S.next(ui + 1, nxt);
        const char* nA = has_next ? (const char*)g.A + (size_t)nxt.pm * tstep : cA; const char* nB = has_next ? (const char*)g.Bt + (size_t)nxt.pn * tstep : cB;
        for (int t = 0; t < nt; t += 2) {
            const bool last = (t == nt - 2);
            const char* a1 = cA + (size_t)(t + 1) * kstep;
            const char* a2 = last ? nA : cA + (size_t)(t + 2) * kstep; const char* b2 = last ? nB : cB + (size_t)(t + 2) * kstep;
            const char* a3 = a2 + kstep; const char* b3 = b2 + kstep;
            if (last && has_next) S.a_ready(nxt);
            if constexpr (SP2) {
            PG8_LDB(B0, 0, 0); PG8_LDB(B1, 0, 1); PG8_SCHED; PG8_LDA(At, 0, 0); PG8_STAGE(PG8_SA(1, 1), a1 + hstep, voffA);
            PG8_WAIT_V(8); PG8_WAIT_L(0); PG8_BAR; PG8_MMA(0, 0, At, B0); PG8_MMA(0, 1, At, B1); PG8_BAR; PG8_SCHED;
            PG8_LDA(At, 0, 1); PG8_STAGE(PG8_SB(0, 0), b2, voffB); PG8_STAGE(PG8_SB(0, 1), b2 + hstep, voffB); PG8_STAGE(PG8_SA(0, 0), a2, voffA);
            PG8_WAIT_V(8); PG8_WAIT_L(0); PG8_BAR; PG8_MMA(1, 0, At, B0); PG8_MMA(1, 1, At, B1); PG8_BAR; PG8_SCHED;
            PG8_LDB(B0, 1, 0); PG8_LDB(B1, 1, 1); PG8_SCHED; PG8_LDA(At, 1, 0); PG8_STAGE(PG8_SA(0, 1), a2 + hstep, voffA);
            PG8_WAIT_V(8); PG8_WAIT_L(0); PG8_BAR; PG8_MMA(0, 0, At, B0); PG8_MMA(0, 1, At, B1); PG8_BAR; PG8_SCHED;
            PG8_LDA(At, 1, 1); PG8_STAGE(PG8_SB(1, 0), b3, voffB); PG8_STAGE(PG8_SB(1, 1), b3 + hstep, voffB); PG8_STAGE(PG8_SA(1, 0), a3, voffA);
            PG8_WAIT_V(8); PG8_WAIT_L(0); PG8_BAR; PG8_MMA(1, 0, At, B0); PG8_MMA(1, 1, At, B1); PG8_BAR; PG8_SCHED;
            } else {
            PG8_LDB(B0, 0, 0); PG8_SCHED; PG8_LDA(At, 0, 0); PG8_STAGE(PG8_SA(1, 1), a1 + hstep, voffA);
            PG8_WAIT_L(8); PG8_BAR; PG8_WAIT_L(0); PG8_MMA(0, 0, At, B0); PG8_BAR; PG8_SCHED;
            PG8_LDB(B1, 0, 1); PG8_STAGE(PG8_SB(0, 0), b2, voffB);
            PG8_BAR; PG8_WAIT_L(0); PG8_MMA(0, 1, At, B1); PG8_BAR;
            PG8_LDA(At, 0, 1); PG8_STAGE(PG8_SA(0, 0), a2, voffA);
            PG8_BAR; PG8_WAIT_L(0); PG8_MMA(1, 0, At, B0); PG8_BAR; PG8_SCHED;
            PG8_STAGE(PG8_SB(0, 1), b2 + hstep, voffB);
            PG8_WAIT_V(6); PG8_BAR; PG8_MMA(1, 1, At, B1); PG8_BAR;
            PG8_LDB(B0, 1, 0); PG8_SCHED; PG8_LDA(At, 1, 0); PG8_STAGE(PG8_SA(0, 1), a2 + hstep, voffA);
            PG8_WAIT_L(8); PG8_BAR; PG8_WAIT_L(0); PG8_MMA(0, 0, At, B0); PG8_BAR; PG8_SCHED;
            PG8_LDB(B1, 1, 1); PG8_STAGE(PG8_SB(1, 0), b3, voffB);
            PG8_BAR; PG8_WAIT_L(0); PG8_MMA(0, 1, At, B1); PG8_BAR;
            PG8_LDA(At, 1, 1); PG8_STAGE(PG8_SA(1, 0), a3, voffA);
            PG8_BAR; PG8_WAIT_L(0); PG8_MMA(1, 0, At, B0); PG8_BAR; PG8_SCHED;
            PG8_STAGE(PG8_SB(1, 1), b3 + hstep, voffB);
            PG8_WAIT_V(6); PG8_BAR; PG8_MMA(1, 1, At, B1); PG8_BAR;
            }
        }
        if constexpr (ALIGN_EPI) { if (wr == 0) PG8_BAR; }
        if constexpr (!Epi::AFTER_DRAIN) { E(acc, cur, wr, wc, fr, fq); S.done(cur); }
        if (!has_next) break;
#pragma unroll
        for (int a = 0; a < 2; ++a)
#pragma unroll
            for (int b = 0; b < 2; ++b)
#pragma unroll
                for (int m = 0; m < 4; ++m)
#pragma unroll
                    for (int n = 0; n < 2; ++n) acc[a][b][m][n] = (f32x4){0.f, 0.f, 0.f, 0.f};
        cur = nxt; cA = nA; cB = nB; ++ui;
        if constexpr (ALIGN_EPI) { if (wr == 1) PG8_BAR; }
    }
    PG8_WAIT_V(0);
    if constexpr (!ALIGN_EPI) { if (wr == 0) PG8_BAR; }
    PG8_BAR;
    if constexpr (Epi::AFTER_DRAIN) { E.fused(acc, cur, wr, wc, fr, fq, lds, wid, lane); S.done(cur); }
#undef PG8_SA
#undef PG8_SB
#undef PG8_STAGE
#undef PG8_LDA
#undef PG8_LDB
#undef PG8_MMA
#undef PG8_WAIT_V
#undef PG8_WAIT_L
#undef PG8_BAR
#undef PG8_SCHED
}
}

constexpr int NWAVES = 8;
constexpr int BATCH = 16, SEQ = 2048, D = 2048, DEPTH = 4, AW = 1024, INW = 10240, FF = 8192, NMODC = 6 * D;
constexpr int M = BATCH * SEQ;
constexpr float EPS = 1e-6f;
#ifndef MK_SINGLE
#define MK_SINGLE 1
#endif
constexpr int N_PHASES = 2 + 9 * DEPTH + 1;

constexpr size_t MiB = 1u << 20;
constexpr size_t WS_CTL = 0, CTL_ZERO_BYTES = 1 * MiB;
constexpr size_t WS_MOD = 1 * MiB;
constexpr size_t WS_LB = 4 * MiB;
constexpr size_t WS_W = 8 * MiB, W_LAYER = 120 * MiB;
constexpr size_t WO_IN = 0, WO_A = 40 * MiB, WO_B = 44 * MiB, WO_OUT = 48 * MiB, WO_F1 = 56 * MiB, WO_F2 = 88 * MiB;
constexpr size_t WS_ACT = WS_W + DEPTH * W_LAYER;
constexpr size_t WS_OG = WS_ACT + 128 * MiB;
constexpr size_t WS_SG = WS_OG + 64 * MiB;
constexpr size_t WS_PROJ = WS_SG + 64 * MiB;
constexpr size_t WS_Q = WS_PROJ, WS_K = WS_Q + 64 * MiB, WS_LF = WS_K + 64 * MiB, WS_V = WS_LF + 128 * MiB, WS_G = WS_V + 64 * MiB, WS_U = WS_G + 64 * MiB, WS_VG = WS_U + 64 * MiB,
                 WS_GB = WS_VG + 64 * MiB, WS_GA = WS_GB + 128 * MiB, WS_END = WS_GA + 128 * MiB;
constexpr size_t WS_HID = WS_PROJ;
constexpr size_t WS_MODP = WS_PROJ;
static_assert(WS_HID + (size_t)M * FF * 2 <= WS_END && WS_MOD + (size_t)DEPTH * BATCH * NMODC * 4 <= WS_LB, "d_ws map");
constexpr int CW_BAR = 4096;

constexpr int RING_OFF = 0, RING_BYTES = 131072;
constexpr int LDSCTL_OFF = RING_BYTES, MISC_OFF = LDSCTL_OFF + 320;
constexpr int LDS_BYTES = 147456;

#define GAS __attribute__((address_space(1)))
#define LAS __attribute__((address_space(3)))
typedef unsigned short bf16;
typedef unsigned v4u __attribute__((ext_vector_type(4)));
typedef unsigned v2u __attribute__((ext_vector_type(2)));
typedef float f32x4 __attribute__((ext_vector_type(4)));
typedef short bf16x8 __attribute__((ext_vector_type(8)));
typedef GAS unsigned gu32;
#define RLX_AGENT __ATOMIC_RELAXED, __HIP_MEMORY_SCOPE_AGENT
#define LDS_WAIT() asm volatile("s_waitcnt lgkmcnt(0)" ::: "memory")
#define VM_WAIT() asm volatile("s_waitcnt vmcnt(0)" ::: "memory")
__device__ __forceinline__ unsigned f2bf(float f) { return (unsigned)__builtin_bit_cast(unsigned short, (__bf16)f); }
__device__ __forceinline__ unsigned pk2(float lo, float hi) { return pg8::cvt_pk_bf16(lo, hi); }
__device__ __forceinline__ float bflo(unsigned w) { return __uint_as_float(w << 16); }
__device__ __forceinline__ float bfhi(unsigned w) { return __uint_as_float(w & 0xffff0000u); }
__device__ __forceinline__ float bf1(bf16 h) { return __uint_as_float(((unsigned)h) << 16); }
__device__ __forceinline__ float wave_sum(float v) {
#pragma unroll
    for (int o = 1; o < 64; o <<= 1) v += __shfl_xor(v, o);
    return v;
}

#define XB_TMO      128
#define XB_XCNT(j)  (256  + 64 * (j))
#define XB_XSUB(j)  (1280 + 64 * (j))
#define XB_XGEN(j)  (2304 + 64 * (j))
#define XB_TOP      3328
#define XB_TOPGEN   3392
#define XCD_BAR_WORDS 3456
#define XB_SPIN_CAP (1u << 18)

__device__ __forceinline__ unsigned xb_ld(unsigned* p)              { return __hip_atomic_load(p, __ATOMIC_RELAXED, __HIP_MEMORY_SCOPE_AGENT); }
__device__ __forceinline__ unsigned xb_add(unsigned* p, unsigned v) { return __hip_atomic_fetch_add(p, v, __ATOMIC_RELAXED, __HIP_MEMORY_SCOPE_AGENT); }
__device__ __forceinline__ unsigned xb_xcc_id() { return (unsigned)__builtin_amdgcn_s_getreg((3 << 11) | 20) & 0xFu; }
#define XB_SPIN(cond, bar) do { unsigned _sp = 0; while (cond) { __builtin_amdgcn_s_sleep(1); \
    if ((++_sp & 255u) == 0u) { if (xb_ld(&(bar)[XB_TMO])) break; if (_sp > XB_SPIN_CAP) { atomicAdd(&(bar)[XB_TMO], 1u); break; } } } } while (0)

struct XcdBarrier {
    unsigned* bar; unsigned x;
    volatile LAS unsigned* st;
};

__device__ __forceinline__ XcdBarrier xcd_barrier_post(unsigned* bar, volatile LAS unsigned* st) {
    XcdBarrier b; b.bar = bar; b.x = xb_xcc_id(); b.st = st;
    if (threadIdx.x == 0) (void)xb_add(&bar[XB_XCNT(b.x)], 1u);
    return b;
}
__device__ __forceinline__ void xcd_barrier_complete(unsigned* bar, unsigned x, unsigned& nloc, unsigned& nx) {
    const unsigned G = gridDim.x * gridDim.y * gridDim.z;
    unsigned sum, cnt, mine, sp = 0u;
    for (;;) {
        sum = 0u; cnt = 0u; mine = 0u;
#pragma unroll
        for (unsigned j = 0; j < 16; ++j) { const unsigned c = xb_ld(&bar[XB_XCNT(j)]); sum += c; cnt += (c > 0u) ? 1u : 0u; mine = (j == x) ? c : mine; }
        if (sum == G) break;
        __builtin_amdgcn_s_sleep(1);
        if ((++sp & 255u) == 0u) { if (xb_ld(&bar[XB_TMO])) break; if (sp > XB_SPIN_CAP) { atomicAdd(&bar[XB_TMO], 1u); break; } }
    }
    nloc = mine > 0u ? mine : 1u; nx = cnt > 0u ? cnt : 1u;
}

__device__ __forceinline__ void xcd_barrier(const XcdBarrier& b) {
    asm volatile("s_waitcnt vmcnt(0)" ::: "memory");
    __syncthreads();
    if (threadIdx.x == 0) {
        unsigned* bar = b.bar;
        __builtin_amdgcn_s_waitcnt(0);
        unsigned nloc = b.st[0], nx = b.st[1];
        if (nloc == 0u) { xcd_barrier_complete(bar, b.x, nloc, nx); b.st[0] = nloc; b.st[1] = nx; }
        const unsigned old = xb_add(&bar[XB_XSUB(b.x)], 1u);
        const unsigned gen = old / nloc;
        if (old + 1u == (gen + 1u) * nloc) {
            __builtin_amdgcn_fence(__ATOMIC_RELEASE, "agent");
            asm volatile("s_waitcnt vmcnt(0)" ::: "memory");
            const unsigned og = xb_add(&bar[XB_TOP], 1u);
            const unsigned tg = og / nx;
            if (og + 1u == (tg + 1u) * nx) xb_add(&bar[XB_TOPGEN], 1u);
            else XB_SPIN(xb_ld(&bar[XB_TOPGEN]) == tg, bar);
            __builtin_amdgcn_fence(__ATOMIC_ACQUIRE, "agent");
            xb_add(&bar[XB_XGEN(b.x)], 1u);
            asm volatile("s_waitcnt vmcnt(0)" ::: "memory");
        } else {
            XB_SPIN(xb_ld(&bar[XB_XGEN(b.x)]) == gen, bar);
            __builtin_amdgcn_fence(__ATOMIC_ACQUIRE, "agent");
            asm volatile("s_waitcnt vmcnt(0)" ::: "memory");
        }
    }
    __syncthreads();
}

struct Frame {
    LAS unsigned char* lds;
    volatile LAS unsigned* MISC;
    gu32* ctl;
    int tid, lane, wave;
    int G, bid;
    unsigned char* ws;
    const float* const* in;
    float* out;
};

__device__ __forceinline__ void p0_transpose_item(const float* W, int K, int N, bf16* WT, LAS float* scr, int item, int lane) {
    const int nblk = N / 32, kb = item / nblk, nb = item % nblk, k0 = 64 * kb, n0 = 32 * nb;
#pragma unroll 8
    for (int i = 0; i < 32; ++i) { const int kk = 2 * i + (lane >> 5); scr[kk * 33 + (lane & 31)] = W[(size_t)(k0 + kk) * N + n0 + (lane & 31)]; }
    LDS_WAIT(); asm volatile("" ::: "memory");
    const int c = lane & 7;
#pragma unroll
    for (int j = 0; j < 4; ++j) { const int n = (lane >> 3) + 8 * j; const LAS float* s = scr + (8 * c) * 33 + n;
        v4u o; o.x = pk2(s[0 * 33], s[1 * 33]); o.y = pk2(s[2 * 33], s[3 * 33]); o.z = pk2(s[4 * 33], s[5 * 33]); o.w = pk2(s[6 * 33], s[7 * 33]);
        *(GAS v4u*)(WT + (size_t)(n0 + n) * K + k0 + 8 * c) = o; }
    LDS_WAIT(); asm volatile("" ::: "memory");
}
__device__ __forceinline__ void p0_mod_item(Frame& F, int item, LAS float* cT) {
    const int ks = item & 7, cb = (item >> 3) % 48, l = item / 384, k0 = 256 * ks, lane = F.lane;
    const float* c = F.in[1]; const float* W = F.in[2] + (size_t)l * D * NMODC;
    for (int idx = lane; idx < 4096; idx += 64) { const int kk = idx & 255, b = idx >> 8; const float x = c[b * D + k0 + kk]; cT[kk * 16 + b] = x * __builtin_amdgcn_rcpf(1.0f + __builtin_amdgcn_exp2f(-1.44269504089f * x)); }
    LDS_WAIT(); asm volatile("" ::: "memory");
    f32x4 acc[16];
#pragma unroll
    for (int b = 0; b < 16; ++b) acc[b] = (f32x4){0.f, 0.f, 0.f, 0.f};
    const float* wp = W + (size_t)k0 * NMODC + cb * 256 + 4 * lane;
#pragma unroll 4
    for (int kk = 0; kk < 256; ++kk) {
        const f32x4 w4 = *(const GAS f32x4*)(wp + (size_t)kk * NMODC);
        const LAS f32x4* cr = (const LAS f32x4*)(cT + kk * 16);
#pragma unroll
        for (int q = 0; q < 4; ++q) { const f32x4 cv = cr[q];
            acc[4 * q + 0] += w4 * cv.x; acc[4 * q + 1] += w4 * cv.y; acc[4 * q + 2] += w4 * cv.z; acc[4 * q + 3] += w4 * cv.w; }
    }
    float* o = (float*)(F.ws + WS_MODP) + ((size_t)(l * 8 + ks) * BATCH) * NMODC + cb * 256 + 4 * lane;
#pragma unroll
    for (int b = 0; b < 16; ++b) *(GAS f32x4*)(o + (size_t)b * NMODC) = acc[b];
    LDS_WAIT(); asm volatile("" ::: "memory");
}
__device__ __forceinline__ void p0a(Frame& F) {
    LAS float* scr = (LAS float*)(F.lds + RING_OFF + F.wave * 16384);
    const int gw = F.bid * NWAVES + F.wave, NGW = F.G * NWAVES;
    for (int it = gw; it < DEPTH * 48 * 8; it += NGW) p0_mod_item(F, it, scr);
    constexpr int I_IN = (D / 64) * (INW / 32), I_A = (AW / 64) * (D / 32), I_O = (D / 64) * (D / 32), I_F1 = (D / 64) * (FF / 32), I_F2 = (FF / 64) * (D / 32);
    constexpr int I_LAYER = I_IN + 2 * I_A + I_O + I_F1 + I_F2;
    for (int it = gw; it < DEPTH * I_LAYER; it += NGW) {
        const int l = it / I_LAYER; int r = it % I_LAYER; unsigned char* wl = F.ws + WS_W + (size_t)l * W_LAYER;
        if (r < I_IN) { p0_transpose_item(F.in[6] + (size_t)l * D * INW, D, INW, (bf16*)(wl + WO_IN), scr, r, F.lane); continue; } r -= I_IN;
        if (r < I_A) { p0_transpose_item(F.in[13] + (size_t)l * AW * D, AW, D, (bf16*)(wl + WO_A), scr, r, F.lane); continue; } r -= I_A;
        if (r < I_A) { p0_transpose_item(F.in[14] + (size_t)l * AW * D, AW, D, (bf16*)(wl + WO_B), scr, r, F.lane); continue; } r -= I_A;
        if (r < I_O) { p0_transpose_item(F.in[15] + (size_t)l * D * D, D, D, (bf16*)(wl + WO_OUT), scr, r, F.lane); continue; } r -= I_O;
        if (r < I_F1) { p0_transpose_item(F.in[16] + (size_t)l * D * FF, D, FF, (bf16*)(wl + WO_F1), scr, r, F.lane); continue; } r -= I_F1;
        p0_transpose_item(F.in[17] + (size_t)l * FF * D, FF, D, (bf16*)(wl + WO_F2), scr, r, F.lane);
    }
}
__device__ __forceinline__ void p0b(Frame& F) {
    const int gt = F.bid * (NWAVES * 64) + F.tid, NT = F.G * NWAVES * 64;
    const float* P = (const float*)(F.ws + WS_MODP); float* MOD = (float*)(F.ws + WS_MOD);
    for (int i = gt; i < DEPTH * BATCH * NMODC; i += NT) {
        const int j = i % NMODC, b = (i / NMODC) % BATCH, l = i / (NMODC * BATCH);
        float s = F.in[3][l * NMODC + j];
#pragma unroll
        for (int ks = 0; ks < 8; ++ks) s += P[((size_t)(l * 8 + ks) * BATCH + b) * NMODC + j];
        const int sec = j / D, col = j % D;
        if (sec == 1) s = F.in[4][l * D + col] * (1.0f + s);
        if (sec == 4) s = F.in[5][l * D + col] * (1.0f + s);
        MOD[i] = s;
    }
    float* LB = (float*)(F.ws + WS_LB);
    for (int k = gt; k < AW; k += NT) {
        float v[DEPTH], mx = -3.0e38f;
#pragma unroll
        for (int l = 0; l < DEPTH; ++l) { v[l] = F.in[7][l * AW + k]; mx = fmaxf(mx, v[l]); }
        float sum = 0.f;
#pragma unroll
        for (int l = 0; l < DEPTH; ++l) { v[l] = __expf(v[l] - mx); sum += v[l]; }
        const float inv = 1.0f / sum; float cum = 0.f;
#pragma unroll
        for (int l = 0; l < DEPTH; ++l) { cum += v[l] * inv; LB[l * AW + k] = cum - v[0] * inv; }
    }
}
__device__ __forceinline__ void norm_phase(Frame& F, const float* x, bf16* h, const float* sh, const float* a) {
    const int gw = F.bid * NWAVES + F.wave, NGW = F.G * NWAVES;
    for (int m = gw; m < M; m += NGW) {
        const GAS f32x4* xr = (const GAS f32x4*)(x + (size_t)m * D) + F.lane; const int b = m / SEQ;
        f32x4 v[8]; float s = 0.f;
#pragma unroll
        for (int j = 0; j < 8; ++j) { v[j] = xr[64 * j]; s += (v[j].x * v[j].x + v[j].y * v[j].y) + (v[j].z * v[j].z + v[j].w * v[j].w); }
        const float rstd = 1.0f / sqrtf(wave_sum(s) * (1.f / D) + EPS);
        const GAS f32x4* ar = (const GAS f32x4*)(a + (size_t)b * NMODC) + F.lane; const GAS f32x4* sr = (const GAS f32x4*)(sh + (size_t)b * NMODC) + F.lane;
        GAS v2u* o = (GAS v2u*)(h + (size_t)m * D) + F.lane;
#pragma unroll
        for (int j = 0; j < 8; ++j) { const f32x4 av = ar[64 * j], sv = sr[64 * j]; const f32x4 y = v[j] * rstd * av + sv; v2u w; w.x = pk2(y.x, y.y); w.y = pk2(y.z, y.w); o[64 * j] = w; }
    }
}
__device__ __forceinline__ void final_norm_phase(Frame& F, const float* x, float* out, const float* g) {
    const int gw = F.bid * NWAVES + F.wave, NGW = F.G * NWAVES;
    for (int m = gw; m < M; m += NGW) {
        const GAS f32x4* xr = (const GAS f32x4*)(x + (size_t)m * D) + F.lane;
        f32x4 v[8]; float s = 0.f;
#pragma unroll
        for (int j = 0; j < 8; ++j) { v[j] = xr[64 * j]; s += (v[j].x * v[j].x + v[j].y * v[j].y) + (v[j].z * v[j].z + v[j].w * v[j].w); }
        const float rstd = 1.0f / sqrtf(wave_sum(s) * (1.f / D) + EPS);
        const GAS f32x4* gr = (const GAS f32x4*)g + F.lane; GAS f32x4* o = (GAS f32x4*)(out + (size_t)m * D) + F.lane;
#pragma unroll
        for (int j = 0; j < 8; ++j) o[64 * j] = v[j] * rstd * gr[64 * j];
    }
}
__device__ __forceinline__ void hgrn_unit(Frame& F, int bh, const float* ng) {
    const int b = bh >> 3, h = bh & 7, tid = F.tid, v = tid & 127, kq = tid >> 7;
    LAS float* sq = (LAS float*)(F.lds + RING_OFF); LAS float* sk = sq + 4096; LAS float* sf = sk + 4096; LAS float* sv = sf + 4096; LAS float* po = sv + 4096;
    const bf16* Qb = (const bf16*)(F.ws + WS_Q); const bf16* Kb = (const bf16*)(F.ws + WS_K); const bf16* Vb = (const bf16*)(F.ws + WS_V); const bf16* Gb = (const bf16*)(F.ws + WS_G);
    const float* LF = (const float*)(F.ws + WS_LF); bf16* OG = (bf16*)(F.ws + WS_OG);
    float S[32];
#pragma unroll
    for (int j = 0; j < 32; ++j) S[j] = 0.f;
    const float ng0 = ng[F.lane], ng1 = ng[F.lane + 64];
    const int st = tid >> 4, sk0 = (tid & 15) * 8;
    for (int c = 0; c < SEQ / 32; ++c) {
        const size_t row0 = (size_t)b * SEQ + c * 32;
        { const size_t go = (row0 + st) * AW + h * 128 + sk0; const int lo = st * 128 + sk0;
          const v4u q8 = *(const GAS v4u*)(Qb + go), k8 = *(const GAS v4u*)(Kb + go), v8 = *(const GAS v4u*)(Vb + go);
          const f32x4 f0 = *(const GAS f32x4*)(LF + go), f1 = *(const GAS f32x4*)(LF + go + 4);
          *(LAS f32x4*)(sq + lo) = (f32x4){bflo(q8.x), bfhi(q8.x), bflo(q8.y), bfhi(q8.y)}; *(LAS f32x4*)(sq + lo + 4) = (f32x4){bflo(q8.z), bfhi(q8.z), bflo(q8.w), bfhi(q8.w)};
          *(LAS f32x4*)(sk + lo) = (f32x4){bflo(k8.x), bfhi(k8.x), bflo(k8.y), bfhi(k8.y)}; *(LAS f32x4*)(sk + lo + 4) = (f32x4){bflo(k8.z), bfhi(k8.z), bflo(k8.w), bfhi(k8.w)};
          *(LAS f32x4*)(sv + lo) = (f32x4){bflo(v8.x), bfhi(v8.x), bflo(v8.y), bfhi(v8.y)}; *(LAS f32x4*)(sv + lo + 4) = (f32x4){bflo(v8.z), bfhi(v8.z), bflo(v8.w), bfhi(v8.w)};
          *(LAS f32x4*)(sf + lo) = (f32x4){__expf(f0.x), __expf(f0.y), __expf(f0.z), __expf(f0.w)}; *(LAS f32x4*)(sf + lo + 4) = (f32x4){__expf(f1.x), __expf(f1.y), __expf(f1.z), __expf(f1.w)}; }
        __syncthreads();
        for (int t = 0; t < 32; ++t) {
            const float vt = sv[t * 128 + v]; float acc = 0.f;
            const LAS f32x4* fq4 = (const LAS f32x4*)(sf + t * 128 + kq * 32); const LAS f32x4* kq4 = (const LAS f32x4*)(sk + t * 128 + kq * 32); const LAS f32x4* qq4 = (const LAS f32x4*)(sq + t * 128 + kq * 32);
#pragma unroll
            for (int j4 = 0; j4 < 8; ++j4) { const f32x4 ff = fq4[j4], kk = kq4[j4], qq = qq4[j4];
                S[4 * j4 + 0] = fmaf(ff.x, S[4 * j4 + 0], kk.x * vt); acc = fmaf(S[4 * j4 + 0], qq.x, acc);
                S[4 * j4 + 1] = fmaf(ff.y, S[4 * j4 + 1], kk.y * vt); acc = fmaf(S[4 * j4 + 1], qq.y, acc);
                S[4 * j4 + 2] = fmaf(ff.z, S[4 * j4 + 2], kk.z * vt); acc = fmaf(S[4 * j4 + 2], qq.z, acc);
                S[4 * j4 + 3] = fmaf(ff.w, S[4 * j4 + 3], kk.w * vt); acc = fmaf(S[4 * j4 + 3], qq.w, acc); }
            po[(kq * 32 + t) * 128 + v] = acc;
        }
        __syncthreads();
#pragma unroll
        for (int tt = 0; tt < 4; ++tt) { const int t = 4 * F.wave + tt;
            float o0 = 0.f, o1 = 0.f;
#pragma unroll
            for (int q = 0; q < 4; ++q) { o0 += po[(q * 32 + t) * 128 + F.lane]; o1 += po[(q * 32 + t) * 128 + F.lane + 64]; }
            const float rstd = 1.0f / sqrtf(wave_sum(o0 * o0 + o1 * o1) * (1.f / 128.f) + EPS);
            const size_t go = (row0 + t) * AW + h * 128 + F.lane;
            OG[go] = (bf16)f2bf(o0 * rstd * ng0 * bf1(Gb[go])); OG[go + 64] = (bf16)f2bf(o1 * rstd * ng1 * bf1(Gb[go + 64])); }
    }
    __syncthreads();
}
constexpr int SG_PITCH = 136;
__device__ __forceinline__ void sgu_unit(Frame& F, int bn, const float* lng, const float* lnb, const float* wsp, const float* bsp) {
    const int tid = F.tid, lane = F.lane, wave = F.wave; const size_t r0 = (size_t)bn * 128;
    LAS bf16* VnT = (LAS bf16*)(F.lds + RING_OFF);
    LAS float* stat = (LAS float*)(F.lds + RING_OFF + 36864);
    const bf16* Vg = (const bf16*)(F.ws + WS_VG); const bf16* Ub = (const bf16*)(F.ws + WS_U); bf16* SG = (bf16*)(F.ws + WS_SG);
    __syncthreads();
    for (int i = 0; i < 16; ++i) { const int t = 16 * wave + i; const bf16* vr = Vg + (r0 + t) * AW;
        const v4u a = *(const GAS v4u*)(vr + 8 * lane), c = *(const GAS v4u*)(vr + 512 + 8 * lane);
        float x[16] = {bflo(a.x), bfhi(a.x), bflo(a.y), bfhi(a.y), bflo(a.z), bfhi(a.z), bflo(a.w), bfhi(a.w), bflo(c.x), bfhi(c.x), bflo(c.y), bfhi(c.y), bflo(c.z), bfhi(c.z), bflo(c.w), bfhi(c.w)};
        float s = 0.f;
#pragma unroll
        for (int j = 0; j < 16; ++j) s += x[j];
        const float mean = wave_sum(s) * (1.f / 1024.f); float q = 0.f;
#pragma unroll
        for (int j = 0; j < 16; ++j) { const float d = x[j] - mean; q += d * d; }
        const float rstd = 1.0f / sqrtf(wave_sum(q) * (1.f / 1024.f) + EPS);
        if (lane == 0) { stat[2 * t] = mean; stat[2 * t + 1] = rstd; } }
    __syncthreads();
    const int fr = lane & 15, fq = lane >> 4;
    for (int g = 0; g < 8; ++g) {
        { const int s = tid >> 2, dq = tid & 3; const float mean = stat[2 * s], rstd = stat[2 * s + 1];
#pragma unroll
          for (int i = 0; i < 4; ++i) { const int d0 = dq * 32 + 8 * i; const v4u a = *(const GAS v4u*)(Vg + (r0 + s) * AW + g * 128 + d0);
              const f32x4 g0 = *(const GAS f32x4*)(lng + g * 128 + d0), g1 = *(const GAS f32x4*)(lng + g * 128 + d0 + 4), b0 = *(const GAS f32x4*)(lnb + g * 128 + d0), b1 = *(const GAS f32x4*)(lnb + g * 128 + d0 + 4);
              const float x[8] = {bflo(a.x), bfhi(a.x), bflo(a.y), bfhi(a.y), bflo(a.z), bfhi(a.z), bflo(a.w), bfhi(a.w)};
              const float gg[8] = {g0.x, g0.y, g0.z, g0.w, g1.x, g1.y, g1.z, g1.w}, bb[8] = {b0.x, b0.y, b0.z, b0.w, b1.x, b1.y, b1.z, b1.w};
#pragma unroll
              for (int j = 0; j < 8; ++j) VnT[(d0 + j) * SG_PITCH + s] = (bf16)f2bf((x[j] - mean) * rstd * gg[j] + bb[j]); } }
        __syncthreads();
        f32x4 acc[8];
#pragma unroll
        for (int nt = 0; nt < 8; ++nt) acc[nt] = (f32x4){0.f, 0.f, 0.f, 0.f};
        const int t = 16 * wave + fr; const float* wr_ = wsp + ((size_t)g * 128 + t) * 128;
#pragma unroll
        for (int ks = 0; ks < 4; ++ks) { const int s0 = 32 * ks + 8 * fq;
            const f32x4 w0 = *(const GAS f32x4*)(wr_ + s0), w1 = *(const GAS f32x4*)(wr_ + s0 + 4);
            const float wv[8] = {w0.x, w0.y, w0.z, w0.w, w1.x, w1.y, w1.z, w1.w}; bf16x8 A;
#pragma unroll
            for (int j = 0; j < 8; ++j) A[j] = (short)f2bf((s0 + j <= t) ? wv[j] : 0.f);
#pragma unroll
            for (int nt = 0; nt < 8; ++nt) { const bf16x8 B = *(const LAS bf16x8*)(VnT + (16 * nt + fr) * SG_PITCH + s0);
                acc[nt] = __builtin_amdgcn_mfma_f32_16x16x32_bf16(A, B, acc[nt], 0, 0, 0); } }
#pragma unroll
        for (int i = 0; i < 4; ++i) { const int to = 16 * wave + 4 * fq + i; const float bs = bsp[g * 128 + to];
#pragma unroll
            for (int nt = 0; nt < 8; ++nt) { const size_t go = (r0 + to) * AW + g * 128 + 16 * nt + fr; SG[go] = (bf16)f2bf((acc[nt][i] + bs) * bf1(Ub[go])); } }
        __syncthreads();
    }
}

constexpr int HG_QT = 0, HG_KT = 8704, HG_KH = 17408, HG_VV = 26624, HG_EBL = 35840, HG_WTOT = 36864, HG_OS = 40960;
constexpr int HG_QP = 272, HG_KP = 72, HG_OP = 132;
struct HgIn { f32x4 lf0, lf1; v4u q8, k8, v8, g8; };
__device__ __forceinline__ void hg_load(HgIn& r, const float* LF, const bf16* Qb, const bf16* Kb, const bf16* Vb, const bf16* Gb, size_t go) {
    r.lf0 = *(const GAS f32x4*)(LF + go); r.lf1 = *(const GAS f32x4*)(LF + go + 4);
    r.q8 = *(const GAS v4u*)(Qb + go); r.k8 = *(const GAS v4u*)(Kb + go); r.v8 = *(const GAS v4u*)(Vb + go); r.g8 = *(const GAS v4u*)(Gb + go);
}
__device__ __forceinline__ bf16x8 hg_frag64x2(const LAS unsigned char* p) {
    const v2u a = *(const LAS v2u*)p, b = *(const LAS v2u*)(p + 32); const v4u r = {a.x, a.y, b.x, b.y}; return __builtin_bit_cast(bf16x8, r);
}
__device__ __forceinline__ void hg_epilogue(LAS unsigned char* L, int et, int ko, const float (&ng8)[8], const v4u g8, bf16* dst) {
    const LAS float* orow = (const LAS float*)(L + HG_OS) + et * HG_OP + 8 * ko;
    const f32x4 o0 = *(const LAS f32x4*)orow, o1 = *(const LAS f32x4*)(orow + 4);
    float ss = (o0.x * o0.x + o0.y * o0.y) + (o0.z * o0.z + o0.w * o0.w) + (o1.x * o1.x + o1.y * o1.y) + (o1.z * o1.z + o1.w * o1.w);
    ss += __shfl_xor(ss, 1); ss += __shfl_xor(ss, 2); ss += __shfl_xor(ss, 4); ss += __shfl_xor(ss, 8);
    const float rstd = 1.0f / sqrtf(ss * (1.f / 128.f) + EPS);
    v4u w;
    w.x = pk2(o0.x * rstd * ng8[0] * bflo(g8.x), o0.y * rstd * ng8[1] * bfhi(g8.x)); w.y = pk2(o0.z * rstd * ng8[2] * bflo(g8.y), o0.w * rstd * ng8[3] * bfhi(g8.y));
    w.z = pk2(o1.x * rstd * ng8[4] * bflo(g8.z), o1.y * rstd * ng8[5] * bfhi(g8.z)); w.w = pk2(o1.z * rstd * ng8[6] * bflo(g8.w), o1.w * rstd * ng8[7] * bfhi(g8.w));
    *(GAS v4u*)dst = w;
}
__device__ __forceinline__ void hgrn_unit_mfma(Frame& F, int bh, const float* ng) {
    const int b = bh >> 3, h = bh & 7, tid = F.tid, lane = F.lane, w = F.wave;
    const int et = tid >> 4, ko = tid & 15, tq = lane >> 4, fr = lane & 15, fq = lane >> 4;
    LAS unsigned char* L = F.lds + RING_OFF;
    const bf16* Qb = (const bf16*)(F.ws + WS_Q); const bf16* Kb = (const bf16*)(F.ws + WS_K); const bf16* Vb = (const bf16*)(F.ws + WS_V); const bf16* Gb = (const bf16*)(F.ws + WS_G);
    const float* LF = (const float*)(F.ws + WS_LF); bf16* OG = (bf16*)(F.ws + WS_OG);
    const size_t go0 = ((size_t)b * SEQ + et) * AW + h * 128 + 8 * ko;
    float ng8[8];
#pragma unroll
    for (int j = 0; j < 8; ++j) ng8[j] = ng[8 * ko + j];
    f32x4 S[8];
#pragma unroll
    for (int T = 0; T < 8; ++T) S[T] = (f32x4){0.f, 0.f, 0.f, 0.f};
    HgIn cur; hg_load(cur, LF, Qb, Kb, Vb, Gb, go0);
    v4u gprev = {0u, 0u, 0u, 0u};
    __syncthreads();
    for (int c = 0; c < SEQ / 32; ++c) {
        float x[8] = {cur.lf0.x, cur.lf0.y, cur.lf0.z, cur.lf0.w, cur.lf1.x, cur.lf1.y, cur.lf1.z, cur.lf1.w};
#pragma unroll
        for (int j = 0; j < 8; ++j) { const float y = __shfl_up(x[j], 16); if (tq >= 1) x[j] += y; }
#pragma unroll
        for (int j = 0; j < 8; ++j) { const float y = __shfl_up(x[j], 32); if (tq >= 2) x[j] += y; }
        if (tq == 3) { LAS float* wt = (LAS float*)(L + HG_WTOT) + w * 128 + 8 * ko; *(LAS f32x4*)wt = (f32x4){x[0], x[1], x[2], x[3]}; *(LAS f32x4*)(wt + 4) = (f32x4){x[4], x[5], x[6], x[7]}; }
        __syncthreads();
        { float off[8], bl[8];
#pragma unroll
          for (int j = 0; j < 8; ++j) { off[j] = 0.f; bl[j] = 0.f; }
#pragma unroll
          for (int w2 = 0; w2 < 8; ++w2) { const LAS float* wt = (const LAS float*)(L + HG_WTOT) + w2 * 128 + 8 * ko; const f32x4 a0 = *(const LAS f32x4*)wt, a1 = *(const LAS f32x4*)(wt + 4);
              const float a[8] = {a0.x, a0.y, a0.z, a0.w, a1.x, a1.y, a1.z, a1.w};
#pragma unroll
              for (int j = 0; j < 8; ++j) { bl[j] += a[j]; if (w2 < w) off[j] += a[j]; } }
          const float qf[8] = {bflo(cur.q8.x), bfhi(cur.q8.x), bflo(cur.q8.y), bfhi(cur.q8.y), bflo(cur.q8.z), bfhi(cur.q8.z), bflo(cur.q8.w), bfhi(cur.q8.w)};
          const float kf[8] = {bflo(cur.k8.x), bfhi(cur.k8.x), bflo(cur.k8.y), bfhi(cur.k8.y), bflo(cur.k8.z), bfhi(cur.k8.z), bflo(cur.k8.w), bfhi(cur.k8.w)};
          float qt[8], kt[8], kh[8];
#pragma unroll
          for (int j = 0; j < 8; ++j) { const float bj = x[j] + off[j]; qt[j] = qf[j] * __expf(bj); kt[j] = kf[j] * __expf(fminf(-bj, 80.f)); kh[j] = kf[j] * __expf(bl[j] - bj); }
          v4u pq, pk; pq.x = pk2(qt[0], qt[1]); pq.y = pk2(qt[2], qt[3]); pq.z = pk2(qt[4], qt[5]); pq.w = pk2(qt[6], qt[7]); pk.x = pk2(kt[0], kt[1]); pk.y = pk2(kt[2], kt[3]); pk.z = pk2(kt[4], kt[5]); pk.w = pk2(kt[6], kt[7]);
          *(LAS v4u*)(L + HG_QT + et * HG_QP + 16 * ko) = pq; *(LAS v4u*)(L + HG_KT + et * HG_QP + 16 * ko) = pk;
          const unsigned vb[4] = {cur.v8.x, cur.v8.y, cur.v8.z, cur.v8.w};
#pragma unroll
          for (int j = 0; j < 8; ++j) { *(LAS bf16*)(L + HG_KH + (8 * ko + j) * HG_KP + 2 * et) = (bf16)f2bf(kh[j]); *(LAS bf16*)(L + HG_VV + (8 * ko + j) * HG_KP + 2 * et) = (bf16)((j & 1) ? (vb[j >> 1] >> 16) : (vb[j >> 1] & 0xffffu)); }
          if (et == 0) { LAS float* eb = (LAS float*)(L + HG_EBL) + 8 * ko; *(LAS f32x4*)eb = (f32x4){__expf(bl[0]), __expf(bl[1]), __expf(bl[2]), __expf(bl[3])}; *(LAS f32x4*)(eb + 4) = (f32x4){__expf(bl[4]), __expf(bl[5]), __expf(bl[6]), __expf(bl[7])}; } }
        if (c > 0) hg_epilogue(L, et, ko, ng8, gprev, OG + go0 + (size_t)(c - 1) * 32 * AW);
        gprev = cur.g8;
        if (c + 1 < SEQ / 32) hg_load(cur, LF, Qb, Kb, Vb, Gb, go0 + (size_t)(c + 1) * 32 * AW);
        __syncthreads();
        { bf16x8 Sb[4];
#pragma unroll
          for (int j = 0; j < 4; ++j) { v4u s; s.x = pk2(S[2 * j][0], S[2 * j][1]); s.y = pk2(S[2 * j][2], S[2 * j][3]); s.z = pk2(S[2 * j + 1][0], S[2 * j + 1][1]); s.w = pk2(S[2 * j + 1][2], S[2 * j + 1][3]); Sb[j] = __builtin_bit_cast(bf16x8, s); }
          f32x4 ao[2] = {{0.f, 0.f, 0.f, 0.f}, {0.f, 0.f, 0.f, 0.f}};
#pragma unroll
          for (int mt = 0; mt < 2; ++mt)
#pragma unroll
              for (int j = 0; j < 4; ++j) ao[mt] = __builtin_amdgcn_mfma_f32_16x16x32_bf16(hg_frag64x2(L + HG_QT + (16 * mt + fr) * HG_QP + (32 * j + 4 * fq) * 2), Sb[j], ao[mt], 0, 0, 0);
          f32x4 sc[2][2] = {{{0.f, 0.f, 0.f, 0.f}, {0.f, 0.f, 0.f, 0.f}}, {{0.f, 0.f, 0.f, 0.f}, {0.f, 0.f, 0.f, 0.f}}};
#pragma unroll
          for (int j = 0; j < 4; ++j) { bf16x8 Ak[2], Bq[2];
#pragma unroll
              for (int m = 0; m < 2; ++m) { Ak[m] = *(const LAS bf16x8*)(L + HG_KT + (16 * m + fr) * HG_QP + (32 * j + 8 * fq) * 2); Bq[m] = *(const LAS bf16x8*)(L + HG_QT + (16 * m + fr) * HG_QP + (32 * j + 8 * fq) * 2); }
#pragma unroll
              for (int ms = 0; ms < 2; ++ms)
#pragma unroll
                  for (int nt = 0; nt < 2; ++nt) sc[ms][nt] = __builtin_amdgcn_mfma_f32_16x16x32_bf16(Ak[ms], Bq[nt], sc[ms][nt], 0, 0, 0); }
          const bf16x8 Bv = hg_frag64x2(L + HG_VV + (16 * w + fr) * HG_KP + (4 * fq) * 2);
#pragma unroll
          for (int nt = 0; nt < 2; ++nt) { const int t = 16 * nt + fr; float p[8];
#pragma unroll
              for (int ms = 0; ms < 2; ++ms)
#pragma unroll
                  for (int i = 0; i < 4; ++i) p[4 * ms + i] = (16 * ms + 4 * fq + i <= t) ? sc[ms][nt][i] : 0.f;
              v4u pp; pp.x = pk2(p[0], p[1]); pp.y = pk2(p[2], p[3]); pp.z = pk2(p[4], p[5]); pp.w = pk2(p[6], p[7]);
              ao[nt] = __builtin_amdgcn_mfma_f32_16x16x32_bf16(__builtin_bit_cast(bf16x8, pp), Bv, ao[nt], 0, 0, 0); }
#pragma unroll
          for (int mt = 0; mt < 2; ++mt)
#pragma unroll
              for (int i = 0; i < 4; ++i) ((LAS float*)(L + HG_OS))[(16 * mt + 4 * fq + i) * HG_OP + 16 * w + fr] = ao[mt][i];
#pragma unroll
          for (int T = 0; T < 8; ++T) { const f32x4 e4 = *(const LAS f32x4*)((const LAS float*)(L + HG_EBL) + 16 * T + 4 * fq);
              S[T] = __builtin_amdgcn_mfma_f32_16x16x32_bf16(hg_frag64x2(L + HG_KH + (16 * T + fr) * HG_KP + (4 * fq) * 2), Bv, S[T] * e4, 0, 0, 0); } }
    }
    __syncthreads();
    hg_epilogue(L, et, ko, ng8, gprev, OG + go0 + (size_t)(SEQ / 32 - 1) * 32 * AW);
    __syncthreads();
}

struct Args { const float* in[19]; float* out; unsigned char* ws; int ph_lo, ph_hi; };
__global__ void __launch_bounds__(NWAVES * 64, 2) hybrid_fwd(Args args) {
    extern __shared__ __attribute__((aligned(16))) unsigned char lds[];
    Frame F;
    F.lds = (LAS unsigned char*)lds;
    F.MISC = (volatile LAS unsigned*)(F.lds + MISC_OFF);
    F.tid = threadIdx.x; F.lane = F.tid & 63; F.wave = __builtin_amdgcn_readfirstlane(F.tid >> 6);
    F.G = gridDim.x; F.bid = blockIdx.x;
    F.ws = args.ws; F.ctl = (gu32*)(args.ws + WS_CTL); F.out = args.out;
    F.in = args.in;
    for (int u = F.tid; u < (LDS_BYTES - LDSCTL_OFF) / 4; u += NWAVES * 64) ((LAS unsigned*)(F.lds + LDSCTL_OFF))[u] = 0u;
    __syncthreads();
    const int lo = args.ph_lo, hi = args.ph_hi;
    XcdBarrier bar; bar.bar = (unsigned*)(F.ctl + CW_BAR); bar.x = 0; bar.st = nullptr;
#ifdef DBG_STOP
    bar = xcd_barrier_post((unsigned*)(F.ctl + CW_BAR), F.MISC + 8);
#else
    if (hi - lo > 1) bar = xcd_barrier_post((unsigned*)(F.ctl + CW_BAR), F.MISC + 8);
#endif
#ifndef REP_G4
#define REP_G4 1
#endif
#ifndef REP_S1
#define REP_S1 1
#endif
#ifndef PH_MASK
#define PH_MASK 0xFFF
#endif
#define PHON(j) ((PH_MASK >> (j)) & 1)
#define IN(k) (lo <= (k) && (k) < hi)
#define FRESH() do { int t_ = threadIdx.x; asm volatile("" : "+v"(t_)); F.tid = t_; F.lane = t_ & 63; } while (0)
#define SEAM(k) do { if (IN(k) && IN((k) + 1)) xcd_barrier(bar); } while (0)
    bf16* ACT = (bf16*)(F.ws + WS_ACT); bf16* OG = (bf16*)(F.ws + WS_OG); bf16* SG = (bf16*)(F.ws + WS_SG); bf16* HID = (bf16*)(F.ws + WS_HID);
    const float* MOD = (const float*)(F.ws + WS_MOD);

    if (PHON(0) && IN(0)) { FRESH(); p0a(F); SEAM(0); }
    if (PHON(1) && IN(1)) { FRESH(); p0b(F); SEAM(1); }
    for (int l = 0; l < DEPTH; ++l) {
        const int pb = 2 + 9 * l;
        const float* MODl = MOD + (size_t)l * BATCH * NMODC;
        const unsigned char* wl = F.ws + WS_W + (size_t)l * W_LAYER;
        const float* xin = (l == 0) ? F.in[0] : (const float*)F.out;
        if (PHON(2) && IN(pb + 0)) { FRESH(); norm_phase(F, xin, ACT, MODl + 0 * D, MODl + 1 * D); SEAM(pb + 0); }
        if (PHON(3) && IN(pb + 1)) {
            pg8::Gemm g{ACT, (const bf16*)(wl + WO_IN), M, INW, D}; pg8::StaticOrder S; S.init(M, INW, F.G, F.bid);
            pg8::EpiProj E{(bf16*)(F.ws + WS_Q), (bf16*)(F.ws + WS_K), (bf16*)(F.ws + WS_V), (bf16*)(F.ws + WS_G), (bf16*)(F.ws + WS_U), (bf16*)(F.ws + WS_VG), (bf16*)(F.ws + WS_GA), (bf16*)(F.ws + WS_GB),
                           (float*)(F.ws + WS_LF), (const float*)(F.ws + WS_LB) + l * AW};
            pg8::gemm_phase<pg8::EpiProj, pg8::StaticOrder, true, true>(F.lds + RING_OFF, g, S, E);
            SEAM(pb + 1);
        }
        for (int rep = 0; rep < REP_S1; ++rep) { if (rep) xcd_barrier(bar);
        if (PHON(4) && IN(pb + 2)) {
            FRESH();
            const float* ng = F.in[8] + l * 128; const float* lng = F.in[9] + l * AW; const float* lnb = F.in[10] + l * AW;
            const float* wsp = F.in[11] + (size_t)l * 8 * 128 * 128; const float* bsp = F.in[12] + l * 8 * 128;
            for (int i = 0;; ++i) {
                int u;
                if (F.G == 256) { if (F.bid < 128) { if (i > 0) break; u = F.bid; } else { if (i > 1) break; u = 128 + 2 * (F.bid - 128) + i; } }
                else { u = F.bid + i * F.G; if (u >= 128 + 256) break; }
                if (u < 128) hgrn_unit_mfma(F, u, ng); else sgu_unit(F, u - 128, lng, lnb, wsp, bsp);
            }
            if (rep == REP_S1 - 1) SEAM(pb + 2);
        } }
        if (PHON(5) && IN(pb + 3)) {
            pg8::Gemm g{OG, (const bf16*)(wl + WO_A), M, D, AW}; pg8::StaticOrder S; S.init(M, D, F.G, F.bid);
            pg8::EpiMerge<false> E{(const bf16*)(F.ws + WS_GA), ACT};
            pg8::gemm_phase<pg8::EpiMerge<false>, pg8::StaticOrder, true, true>(F.lds + RING_OFF, g, S, E);
            SEAM(pb + 3);
        }
        if (PHON(6) && IN(pb + 4)) {
            pg8::Gemm g{SG, (const bf16*)(wl + WO_B), M, D, AW}; pg8::StaticOrder S; S.init(M, D, F.G, F.bid);
            pg8::EpiMerge<true> E{(const bf16*)(F.ws + WS_GB), ACT};
            pg8::gemm_phase<pg8::EpiMerge<true>, pg8::StaticOrder, true, true>(F.lds + RING_OFF, g, S, E);
            SEAM(pb + 4);
        }
        if (PHON(7) && IN(pb + 5)) {
            pg8::Gemm g{ACT, (const bf16*)(wl + WO_OUT), M, D, D}; pg8::StaticOrder S; S.init(M, D, F.G, F.bid);
            pg8::EpiResid E{xin, F.out, MODl + 2 * D};
            pg8::gemm_phase<pg8::EpiResid, pg8::StaticOrder, true, true>(F.lds + RING_OFF, g, S, E);
            SEAM(pb + 5);
        }
        if (PHON(8) && IN(pb + 6)) { FRESH(); norm_phase(F, F.out, ACT, MODl + 3 * D, MODl + 4 * D); SEAM(pb + 6); }
        for (int rep = 0; rep < REP_G4; ++rep) { if (rep) xcd_barrier(bar);
        if (PHON(9) && IN(pb + 7)) {
            pg8::Gemm g{ACT, (const bf16*)(wl + WO_F1), M, FF, D}; pg8::StaticOrder S; S.init(M, FF, F.G, F.bid);
            pg8::EpiRelu2 E{HID};
            pg8::gemm_phase<pg8::EpiRelu2, pg8::StaticOrder, true, true>(F.lds + RING_OFF, g, S, E);
            if (rep == REP_G4 - 1) SEAM(pb + 7);
        } }
        if (PHON(10) && IN(pb + 8)) {
            pg8::Gemm g{HID, (const bf16*)(wl + WO_F2), M, D, FF}; pg8::StaticOrder S; S.init(M, D, F.G, F.bid);
            pg8::EpiResid E{F.out, F.out, MODl + 5 * D};
            pg8::gemm_phase<pg8::EpiResid, pg8::StaticOrder, true, true>(F.lds + RING_OFF, g, S, E);
            SEAM(pb + 8);
        }
    }
    if (PHON(11) && IN(N_PHASES - 1)) { FRESH(); final_norm_phase(F, F.out, F.out, F.in[18]); }
#ifdef DBG_STOP
    xcd_barrier(bar);
    if (DBG_BUF >= 0) { FRESH(); const bf16* src = (const bf16*)(F.ws + (size_t)DBG_BUF * MiB); const size_t n = (size_t)M * D, NT = (size_t)F.G * NWAVES * 64;
      for (size_t i = (size_t)F.bid * (NWAVES * 64) + F.tid; i < n; i += NT) F.out[i] = DBG_F32 ? ((const float*)src)[i] : bf1(src[i]); }
#endif
#undef IN
#undef SEAM
}

extern "C" void kernel_launch(void* const* d_in, const int* in_sizes, int n_in, void* d_out, int out_size, void* d_ws, size_t ws_size, hipStream_t stream) {
    static int grid = 0;
    if (grid == 0) {
        if (n_in != 19 || in_sizes[0] != M * D || out_size != M * D || ws_size < WS_END) { fprintf(stderr, "kernel_launch: unexpected shapes: n_in %d in0 %d out %d ws %zu (need %zu)\n", n_in, n_in > 0 ? in_sizes[0] : -1, out_size, ws_size, (size_t)WS_END); grid = -1; return; }
        int dev = 0, cus = 0, per_cu = 0;
        if (hipGetDevice(&dev) != hipSuccess || hipDeviceGetAttribute(&cus, hipDeviceAttributeMultiprocessorCount, dev) != hipSuccess) { grid = -1; return; }
        if (hipFuncSetAttribute((const void*)hybrid_fwd, hipFuncAttributeMaxDynamicSharedMemorySize, LDS_BYTES) != hipSuccess) { fprintf(stderr, "kernel_launch: hipFuncSetAttribute failed\n"); grid = -1; return; }
        if (hipOccupancyMaxActiveBlocksPerMultiprocessor(&per_cu, (const void*)hybrid_fwd, NWAVES * 64, LDS_BYTES) != hipSuccess || per_cu < 1) fprintf(stderr, "kernel_launch: occupancy query reports %d\n", per_cu);
        (void)hipGetLastError();
        grid = cus;
    }
    if (grid < 0) return;
    if (hipMemsetAsync((char*)d_ws + WS_CTL, 0, CTL_ZERO_BYTES, stream) != hipSuccess) return;
    Args a{};
    for (int i = 0; i < 19; ++i) a.in[i] = (const float*)d_in[i];
    a.out = (float*)d_out; a.ws = (unsigned char*)d_ws;
#if MK_SINGLE
#ifdef DBG_STOP
    a.ph_lo = 0; a.ph_hi = DBG_STOP;
#else
    a.ph_lo = 0; a.ph_hi = N_PHASES;
#endif
    hipLaunchKernelGGL(hybrid_fwd, dim3(grid), dim3(NWAVES * 64), LDS_BYTES, stream, a);
#else
    for (int k = 0; k < N_PHASES; ++k) { a.ph_lo = k; a.ph_hi = k + 1; hipLaunchKernelGGL(hybrid_fwd, dim3(grid), dim3(NWAVES * 64), LDS_BYTES, stream, a); }
#endif
}
```

```cpp
#include <hip/hip_runtime.h>
#include <cstdio>
#include <cstdint>
namespace pg8 {
#define PG8_LAS __attribute__((address_space(3)))
typedef unsigned short bf16_t;
typedef short bf16x8 __attribute__((ext_vector_type(8)));
typedef float f32x4 __attribute__((ext_vector_type(4)));
typedef unsigned u32x4 __attribute__((ext_vector_type(4)));
constexpr int BM = 256, BK = 64, HALF = 128, HTB = HALF * BK * 2  , STAGE_BYTES = 8 * HTB, NXCD = 8, WGM = 8;

__host__ __device__ __forceinline__ int lds_byte(int r, int c) { const int st = (r >> 4) * 2 + (c >> 5), rr = r & 15, cc = c & 31, ob = rr * 64 + cc * 2; return st * 1024 + (ob ^ (((ob >> 9) & 1) << 5)); }
__host__ __device__ __forceinline__ void stage_rc(int b, int& R, int& C) { const int st = b / 1024, sb = b % 1024, swz = sb ^ (((sb >> 9) & 1) << 5); R = (st >> 1) * 16 + swz / 64; C = (st & 1) * 32 + (swz % 64) / 2; }
__host__ __device__ __forceinline__ int perm32(int rho) { const int n = rho >> 4, i = rho & 15; return 8 * (i >> 2) + 4 * n + (i & 3); }

struct Unit { int pm, pn; };
struct Gemm { const bf16_t* A; const bf16_t* Bt; int M, N, K; size_t agshift; int wid; };
__device__ __forceinline__ int lane_now() { int l_; asm volatile("v_mbcnt_lo_u32_b32 %0, -1, 0\n\tv_mbcnt_hi_u32_b32 %0, -1, %0" : "=&v"(l_)); return l_; }
__device__ __forceinline__ float wshfl(float v, int src) { return __int_as_float(__builtin_amdgcn_ds_bpermute(src << 2, __float_as_int(v))); }
__device__ __forceinline__ float wshfl_xor(float v, int mask, int lane) { return wshfl(v, lane ^ mask); }

struct StaticOrder {
    int nM, nN, nwg, G, c;
    __host__ __device__ void init(int M, int N, int G_, int c_) { nM = M / BM; nN = N / BM; nwg = nM * nN; G = G_; c = c_; }
    __host__ __device__ bool next(int i, Unit& u) const {
        const long L = (long)i * G + c; if (L >= nwg) return false;
        int wgid = (int)L; { const int q = nwg / NXCD, r = nwg % NXCD, xcd = wgid % NXCD, off = wgid / NXCD; wgid = (xcd < r ? xcd * (q + 1) : r * (q + 1) + (xcd - r) * q) + off; }
        const int nig = WGM * nN, gid = wgid / nig, fm = gid * WGM, gsz = (nM - fm) < WGM ? (nM - fm) : WGM;
        u.pm = fm + ((wgid % nig) % gsz); u.pn = (wgid % nig) / gsz; return true;
    }
    __device__ __forceinline__ void a_ready(const Unit&) const {}
    __device__ __forceinline__ void done(const Unit&) const {}
};
typedef float f32x2 __attribute__((ext_vector_type(2)));
typedef __bf16 bf16x2_t __attribute__((ext_vector_type(2)));
__device__ __forceinline__ unsigned cvt_pk_bf16(float lo, float hi) { const f32x2 v = {lo, hi}; return __builtin_bit_cast(unsigned, __builtin_convertvector(v, bf16x2_t)); }
__device__ __forceinline__ f32x2 gelu_pk(f32x2 v) {
    const f32x2 av = __builtin_elementwise_abs(v), d = av * 0.2316418882f + 1.0f;
    f32x2 t; t.x = __builtin_amdgcn_rcpf(d.x); t.y = __builtin_amdgcn_rcpf(d.y);
    f32x2 q = t * 0.5307027145f + (-0.7265760135f); q = q * t + 0.7107068705f; q = q * t + (-0.142248368f); q = q * t + 0.127414796f; q = q * t;
    const f32x2 s = (v * v) * (-0.72134752044f);
    f32x2 e; e.x = __builtin_amdgcn_exp2f(s.x); e.y = __builtin_amdgcn_exp2f(s.y);
    const f32x2 m = v * (q * e), r = v - m;
    f32x2 o; o.x = v.x < 0.f ? m.x : r.x; o.y = v.y < 0.f ? m.y : r.y; return o;
}

__device__ __forceinline__ float fsigmoid(float x) { return __builtin_amdgcn_rcpf(1.0f + __builtin_amdgcn_exp2f(-1.44269504089f * x)); }
__device__ __forceinline__ float bf_lo(unsigned w) { return __uint_as_float(w << 16); }
__device__ __forceinline__ float bf_hi(unsigned w) { return __uint_as_float(w & 0xffff0000u); }
template <int ACT> __device__ __forceinline__ void act8(f32x4& v0, f32x4& v1) {
    if (ACT == 1) {
#pragma unroll
        for (int j = 0; j < 4; ++j) { v0[j] = v0[j] * fsigmoid(v0[j]); v1[j] = v1[j] * fsigmoid(v1[j]); } }
    if (ACT == 2) { f32x2 a = gelu_pk((f32x2){v0[0], v0[1]}), b = gelu_pk((f32x2){v0[2], v0[3]}), c = gelu_pk((f32x2){v1[0], v1[1]}), d = gelu_pk((f32x2){v1[2], v1[3]});
        v0 = (f32x4){a.x, a.y, b.x, b.y}; v1 = (f32x4){c.x, c.y, d.x, d.y}; }
    if (ACT == 3) {
#pragma unroll
        for (int j = 0; j < 4; ++j) { v0[j] = fsigmoid(v0[j]); v1[j] = fsigmoid(v1[j]); } }
    if (ACT == 4) {
#pragma unroll
        for (int j = 0; j < 4; ++j) { const float a = fmaxf(v0[j], 0.f), b = fmaxf(v1[j], 0.f); v0[j] = a * a; v1[j] = b * b; } }
}
typedef const PG8_LAS float* lfp;
__device__ __forceinline__ f32x4 ld4(const float* p) { return *(const f32x4*)p; }
__device__ __forceinline__ f32x4 ld4(lfp p) { return *(const PG8_LAS f32x4*)p; }
constexpr int STASH_OFF = 133120, STASH_SLOT = 3072;
struct Stash { unsigned long long a; float b, c; };
__device__ __forceinline__ void stash_rows(lfp slot, int rl, float (&rs)[2][4]) {
#pragma unroll
    for (int ai = 0; ai < 2; ++ai)
#pragma unroll
        for (int m = 0; m < 4; ++m) rs[ai][m] = slot[rl + ai * HALF + m * 16];
}
template <int ACT, class CP> __device__ __forceinline__ void store_act(const f32x4 (&acc)[2][2][4][2], bf16_t* dst, int ldc, int row0, int col0, const float (&rs)[2][4], const CP cp) {
    f32x4 cv[2][2];
#pragma unroll
    for (int bj = 0; bj < 2; ++bj) { cv[bj][0] = ld4(cp + bj * HALF); cv[bj][1] = ld4(cp + bj * HALF + 4); }
#pragma unroll
    for (int ai = 0; ai < 2; ++ai)
#pragma unroll
        for (int m = 0; m < 4; ++m) { bf16_t* rowp = dst + (size_t)(row0 + ai * HALF + m * 16) * ldc + col0;
#pragma unroll
            for (int bj = 0; bj < 2; ++bj) { f32x4 v0 = acc[ai][bj][m][0] * rs[ai][m] + cv[bj][0], v1 = acc[ai][bj][m][1] * rs[ai][m] + cv[bj][1];
                act8<ACT>(v0, v1);
                u32x4 w; w.x = cvt_pk_bf16(v0[0], v0[1]); w.y = cvt_pk_bf16(v0[2], v0[3]); w.z = cvt_pk_bf16(v1[0], v1[1]); w.w = cvt_pk_bf16(v1[2], v1[3]);
                *(u32x4*)(rowp + bj * HALF) = w; }
            asm volatile("" ::: "memory"); }
}
typedef unsigned long long ssq_t;
constexpr float SSQ_SCALE = 16777216.0f, SSQ_INV = 1.0f / 16777216.0f;
__device__ __forceinline__ ssq_t ssq_fix(float s) { return (ssq_t)(s * SSQ_SCALE + 0.5f); }
__device__ __forceinline__ float ssq_val(ssq_t v) { return (float)v * SSQ_INV; }
__device__ __forceinline__ void load_row_scale(const ssq_t* ssq, int row0, float (&rs)[2][4]) {
    asm volatile("" ::: "memory");
#pragma unroll
    for (int ai = 0; ai < 2; ++ai)
#pragma unroll
        for (int m = 0; m < 4; ++m) rs[ai][m] = __builtin_amdgcn_rsqf(ssq_val(ssq[row0 + ai * HALF + m * 16]) * (1.0f / 2048.0f) + 1e-6f);
}
struct EpiProj {
    static constexpr bool PERM = true, AFTER_DRAIN = false, PRELOAD = false, MID = false, STASH = true;
    __device__ __forceinline__ Stash stash_load(const Unit& u, int t) const { Stash s; s.a = 0; s.b = 0.f; s.c = 0.f;
        if (t < 256) s.a = ssq[u.pm * BM + t]; else { s.b = cmat[(size_t)(u.pm >> 3) * 10240 + u.pn * BM + (t - 256)]; s.c = lb[(u.pn & 3) * BM + (t - 256)]; }
        return s; }
    __device__ __forceinline__ void stash_write(const Stash& s, PG8_LAS unsigned char* slot, int t) const {
        if (t < 256) ((PG8_LAS float*)slot)[t] = __builtin_amdgcn_rsqf(ssq_val(s.a) * (1.0f / 2048.0f) + 1e-6f); else { ((PG8_LAS float*)slot)[t] = s.b; ((PG8_LAS float*)slot)[t + 256] = s.c; } }
    bf16_t *Qb, *Kb, *Vb, *Gb, *Ub, *Vgb, *GA, *GB; float* LF; const float* lb; const ssq_t* ssq; const float* cmat;
    __device__ __forceinline__ void operator()(const f32x4 (&acc)[2][2][4][2], const Unit& u, int wr, int wc, int fr, int fq, const PG8_LAS unsigned char* slot) const {
        int fq_ = fq, fr_ = fr; asm volatile("" : "+v"(fq_), "+v"(fr_));
        const int seg = u.pn >> 2, row0 = u.pm * BM + wr * 64 + fr_, cw = wc * 32 + 8 * fq_, c4 = (u.pn & 3) * BM + cw;
        float rs[2][4]; stash_rows((lfp)slot, wr * 64 + fr_, rs);
        const lfp cp = (lfp)slot + 256 + cw, lbl = (lfp)slot + 512 + cw;
        const size_t g2 = (size_t)(u.pm >> 4) * (size_t)(88u << 19), g4 = (size_t)(u.pm >> 4) * (size_t)(80u << 19);
        if (seg == 1) {
            int tl_ = lane_now(); asm volatile("" : "+v"(tl_));
            const int lane15 = (tl_ & 48) | 15;
#pragma unroll
            for (int bj = 0; bj < 2; ++bj) {
                const f32x4 cv0 = ld4(cp + bj * HALF), cv1 = ld4(cp + bj * HALF + 4), lv0 = ld4(lbl + bj * HALF), lv1 = ld4(lbl + bj * HALF + 4);
#pragma unroll
                for (int ai = 0; ai < 2; ++ai)
#pragma unroll
                    for (int ch = 0; ch < 2; ++ch) { float carry[8];
#pragma unroll
                        for (int mm = 0; mm < 2; ++mm) { const int m = 2 * ch + mm; const size_t ro = (size_t)(row0 + ai * HALF + m * 16) * 1024 + c4 + bj * HALF;
                            const f32x4 v[2] = {acc[ai][bj][m][0] * rs[ai][m] + cv0, acc[ai][bj][m][1] * rs[ai][m] + cv1}; float g[8], kk[8];
#pragma unroll
                            for (int j = 0; j < 8; ++j) { const float x = fminf(fmaxf(v[j >> 2][j & 3], -80.f), 80.f), e = __builtin_amdgcn_exp2f(-1.44269504089f * x), s = __builtin_amdgcn_rcpf(1.0f + e), lbv = (j < 4) ? lv0[j & 3] : lv1[j & 3], om = 1.0f - lbv;
                                g[j] = 0.69314718056f * __builtin_amdgcn_logf(fmaxf(lbv + om * s, 1e-20f)); kk[j] = om * (e * s); }
#pragma unroll
                            for (int j = 0; j < 8; ++j) {
                                float x = g[j];
                                x += __builtin_bit_cast(float, __builtin_amdgcn_update_dpp(0, __builtin_bit_cast(int, x), 0x111, 0xf, 0xf, true));
                                x += __builtin_bit_cast(float, __builtin_amdgcn_update_dpp(0, __builtin_bit_cast(int, x), 0x112, 0xf, 0xf, true));
                                x += __builtin_bit_cast(float, __builtin_amdgcn_update_dpp(0, __builtin_bit_cast(int, x), 0x114, 0xf, 0xf, true));
                                x += __builtin_bit_cast(float, __builtin_amdgcn_update_dpp(0, __builtin_bit_cast(int, x), 0x118, 0xf, 0xf, true));
                                if (mm == 0) carry[j] = wshfl(x, lane15); else x += carry[j];
                                g[j] = x; }
                            u32x4 w; w.x = cvt_pk_bf16(kk[0], kk[1]); w.y = cvt_pk_bf16(kk[2], kk[3]); w.z = cvt_pk_bf16(kk[4], kk[5]); w.w = cvt_pk_bf16(kk[6], kk[7]);
                            *(u32x4*)(Kb + g2 + ro) = w; *(f32x4*)(LF + (g4 >> 1) + ro) = (f32x4){g[0], g[1], g[2], g[3]}; *(f32x4*)(LF + (g4 >> 1) + ro + 4) = (f32x4){g[4], g[5], g[6], g[7]}; }
                        asm volatile("" ::: "memory"); } }
            return;
        }
        if (seg == 0) store_act<1>(acc, Qb + g2, 1024, row0, c4, rs, cp);
        else if (seg == 2) store_act<0>(acc, Vb + g2, 1024, row0, c4, rs, cp);
        else if (seg == 3) store_act<1>(acc, Gb + g2, 1024, row0, c4, rs, cp);
        else if (seg == 4) store_act<2>(acc, Ub + g2, 1024, row0, c4, rs, cp);
        else if (seg == 5) store_act<2>(acc, Vgb + g2, 1024, row0, c4, rs, cp);
        else {
            const int gc = (u.pn - 24) * HALF + cw;
            const f32x4 ca0 = ld4(cp), ca1 = ld4(cp + 4), cb0 = ld4(cp + HALF), cb1 = ld4(cp + HALF + 4);
#pragma unroll
            for (int ai = 0; ai < 2; ++ai)
#pragma unroll
                for (int m = 0; m < 4; ++m) { const size_t ro = (size_t)(row0 + ai * HALF + m * 16) * 2048 + gc;
                    f32x4 a0 = acc[ai][0][m][0] * rs[ai][m] + ca0, a1 = acc[ai][0][m][1] * rs[ai][m] + ca1, b0 = acc[ai][1][m][0] * rs[ai][m] + cb0, b1 = acc[ai][1][m][1] * rs[ai][m] + cb1;
#pragma unroll
                    for (int j = 0; j < 4; ++j) { b0[j] = fmaxf(fsigmoid(b0[j]), 1e-30f); b1[j] = fmaxf(fsigmoid(b1[j]), 1e-30f); a0[j] = fsigmoid(a0[j]) * __builtin_amdgcn_rcpf(b0[j]); a1[j] = fsigmoid(a1[j]) * __builtin_amdgcn_rcpf(b1[j]); }
                    u32x4 wr_, wb_; wr_.x = cvt_pk_bf16(a0[0], a0[1]); wr_.y = cvt_pk_bf16(a0[2], a0[3]); wr_.z = cvt_pk_bf16(a1[0], a1[1]); wr_.w = cvt_pk_bf16(a1[2], a1[3]);
                    wb_.x = cvt_pk_bf16(b0[0], b0[1]); wb_.y = cvt_pk_bf16(b0[2], b0[3]); wb_.z = cvt_pk_bf16(b1[0], b1[1]); wb_.w = cvt_pk_bf16(b1[2], b1[3]);
                    *(u32x4*)(GA + g4 + ro) = wr_; *(u32x4*)(GB + g4 + ro) = wb_;
                    asm volatile("" ::: "memory"); }
        }
    }
};
template <bool ADD> struct EpiMerge {
    static constexpr bool PERM = true, AFTER_DRAIN = false, PRELOAD = false, MID = false, STASH = false;
    const bf16_t* gate0; bf16_t* out;
    __device__ __forceinline__ void operator()(const f32x4 (&acc)[2][2][4][2], const Unit& u, int wr, int wc, int fr, int fq) const {
        const int row0 = u.pm * BM + wr * 64 + fr, col0 = u.pn * BM + wc * 32 + 8 * fq;
        const bf16_t* gate = gate0 + (size_t)(u.pm >> 4) * (size_t)(80u << 19);
        constexpr int MB = ADD ? 2 : 4;
#pragma unroll
        for (int ai = 0; ai < 2; ++ai)
#pragma unroll
          for (int mb = 0; mb < 4; mb += MB) {
            u32x4 g[MB][2], o[MB][2];
#pragma unroll
            for (int m = 0; m < MB; ++m)
#pragma unroll
                for (int bj = 0; bj < 2; ++bj) { const size_t ro = (size_t)(row0 + ai * HALF + (mb + m) * 16) * 2048 + col0 + bj * HALF;
                    g[m][bj] = *(const u32x4*)(gate + ro); if (ADD) o[m][bj] = *(const u32x4*)(out + ro); }
            asm volatile("" ::: "memory");
#pragma unroll
            for (int m = 0; m < MB; ++m)
#pragma unroll
                for (int bj = 0; bj < 2; ++bj) { const size_t ro = (size_t)(row0 + ai * HALF + (mb + m) * 16) * 2048 + col0 + bj * HALF;
                    f32x4 v0 = acc[ai][bj][mb + m][0], v1 = acc[ai][bj][mb + m][1]; const u32x4 gg = g[m][bj];
                    v0[0] *= bf_lo(gg.x); v0[1] *= bf_hi(gg.x); v0[2] *= bf_lo(gg.y); v0[3] *= bf_hi(gg.y); v1[0] *= bf_lo(gg.z); v1[1] *= bf_hi(gg.z); v1[2] *= bf_lo(gg.w); v1[3] *= bf_hi(gg.w);
                    if (ADD) { const u32x4 oo = o[m][bj];
                        v0[0] += bf_lo(oo.x); v0[1] += bf_hi(oo.x); v0[2] += bf_lo(oo.y); v0[3] += bf_hi(oo.y); v1[0] += bf_lo(oo.z); v1[1] += bf_hi(oo.z); v1[2] += bf_lo(oo.w); v1[3] += bf_hi(oo.w); }
                    u32x4 w; w.x = cvt_pk_bf16(v0[0], v0[1]); w.y = cvt_pk_bf16(v0[2], v0[3]); w.z = cvt_pk_bf16(v1[0], v1[1]); w.w = cvt_pk_bf16(v1[2], v1[3]);
                    *(u32x4*)(out + ro) = w; }
            asm volatile("" ::: "memory");
          }
    }
};
struct EpiMerge2 {
    static constexpr bool PERM = true, AFTER_DRAIN = false, PRELOAD = false, MID = true, STASH = false;
    const bf16_t* ga0; const bf16_t* gb0; bf16_t* out;
    __device__ __forceinline__ void mid(f32x4 (&acc)[2][2][4][2], const Unit& u, int wr, int wc, int fr, int fq) const {
        int fq_ = fq, fr_ = fr; asm volatile("" : "+v"(fq_), "+v"(fr_));
        const int row0 = u.pm * BM + wr * 64 + fr_, col0 = u.pn * BM + wc * 32 + 8 * fq_; const bf16_t* ga = ga0 + (size_t)(u.pm >> 4) * (size_t)(80u << 19);
#pragma unroll
        for (int ai = 0; ai < 2; ++ai) { u32x4 a[4][2];
#pragma unroll
            for (int m = 0; m < 4; ++m)
#pragma unroll
                for (int bj = 0; bj < 2; ++bj) a[m][bj] = *(const u32x4*)(ga + (size_t)(row0 + ai * HALF + m * 16) * 2048 + col0 + bj * HALF);
            asm volatile("" ::: "memory");
#pragma unroll
            for (int m = 0; m < 4; ++m)
#pragma unroll
                for (int bj = 0; bj < 2; ++bj) { const u32x4 x = a[m][bj];
                    acc[ai][bj][m][0] = acc[ai][bj][m][0] * (f32x4){bf_lo(x.x), bf_hi(x.x), bf_lo(x.y), bf_hi(x.y)}; acc[ai][bj][m][1] = acc[ai][bj][m][1] * (f32x4){bf_lo(x.z), bf_hi(x.z), bf_lo(x.w), bf_hi(x.w)}; }
            asm volatile("" ::: "memory"); }
    }
    __device__ __forceinline__ void operator()(const f32x4 (&acc)[2][2][4][2], const Unit& u, int wr, int wc, int fr, int fq) const {
        int fq_ = fq, fr_ = fr; asm volatile("" : "+v"(fq_), "+v"(fr_));
        const int row0 = u.pm * BM + wr * 64 + fr_, col0 = u.pn * BM + wc * 32 + 8 * fq_; const bf16_t* gb = gb0 + (size_t)(u.pm >> 4) * (size_t)(80u << 19);
#pragma unroll
        for (int ai = 0; ai < 2; ++ai) { u32x4 b[4][2];
#pragma unroll
            for (int m = 0; m < 4; ++m)
#pragma unroll
                for (int bj = 0; bj < 2; ++bj) b[m][bj] = *(const u32x4*)(gb + (size_t)(row0 + ai * HALF + m * 16) * 2048 + col0 + bj * HALF);
            asm volatile("" ::: "memory");
#pragma unroll
            for (int m = 0; m < 4; ++m)
#pragma unroll
                for (int bj = 0; bj < 2; ++bj) { const u32x4 y = b[m][bj]; f32x4 v0 = acc[ai][bj][m][0], v1 = acc[ai][bj][m][1];
                    v0[0] *= fmaxf(bf_lo(y.x), 1e-30f); v0[1] *= fmaxf(bf_hi(y.x), 1e-30f); v0[2] *= fmaxf(bf_lo(y.y), 1e-30f); v0[3] *= fmaxf(bf_hi(y.y), 1e-30f);
                    v1[0] *= fmaxf(bf_lo(y.z), 1e-30f); v1[1] *= fmaxf(bf_hi(y.z), 1e-30f); v1[2] *= fmaxf(bf_lo(y.w), 1e-30f); v1[3] *= fmaxf(bf_hi(y.w), 1e-30f);
                    u32x4 w; w.x = cvt_pk_bf16(v0[0], v0[1]); w.y = cvt_pk_bf16(v0[2], v0[3]); w.z = cvt_pk_bf16(v1[0], v1[1]); w.w = cvt_pk_bf16(v1[2], v1[3]);
                    *(u32x4*)(out + (size_t)(row0 + ai * HALF + m * 16) * 2048 + col0 + bj * HALF) = w; }
            asm volatile("" ::: "memory"); }
    }
};
typedef unsigned u32x2 __attribute__((ext_vector_type(2)));
struct EpiResid {
    static constexpr bool PERM = true, AFTER_DRAIN = false, PRELOAD = true, MID = false, STASH = false;
    const float* xin32; const bf16_t* xin16; bf16_t* xout; const float* gt; const float* avec; bf16_t* xa; ssq_t* ssq;
    __device__ __forceinline__ f32x4 gate4(int b, int col) const {
        f32x4 gq = *(const f32x4*)(gt + (size_t)b * 12288 + col);
#pragma unroll
        for (int j = 0; j < 4; ++j) gq[j] = (__builtin_fabsf(gq[j]) < 1e-12f) ? __builtin_copysignf(1e-12f, gq[j]) : gq[j];
        return gq;
    }
    __device__ __forceinline__ void init(f32x4 (&acc)[2][2][4][2], const Unit& u, int wr, int wc, int fr, int fq) const {
        const int row0 = u.pm * BM + wr * 64 + fr, col0 = u.pn * BM + wc * 32 + 8 * fq, b = u.pm >> 3;
        if (xin32) {
#pragma unroll
            for (int ai = 0; ai < 2; ++ai)
#pragma unroll
                for (int m = 0; m < 4; ++m)
#pragma unroll
                    for (int bj = 0; bj < 2; ++bj)
#pragma unroll
                        for (int n = 0; n < 2; ++n) acc[ai][bj][m][n] = *(const f32x4*)(xin32 + (size_t)(row0 + ai * HALF + m * 16) * 2048 + col0 + bj * HALF + n * 4);
            asm volatile("" ::: "memory");
        } else {
#pragma unroll
            for (int ai = 0; ai < 2; ++ai)
#pragma unroll
                for (int m = 0; m < 4; ++m)
#pragma unroll
                    for (int bj = 0; bj < 2; ++bj) acc[ai][bj][m][0] = __builtin_bit_cast(f32x4, *(const u32x4*)(xin16 + (size_t)(row0 + ai * HALF + m * 16) * 2048 + col0 + bj * HALF));
            asm volatile("" ::: "memory");
#pragma unroll
            for (int ai = 0; ai < 2; ++ai)
#pragma unroll
                for (int m = 0; m < 4; ++m)
#pragma unroll
                    for (int bj = 0; bj < 2; ++bj) { const u32x4 r = __builtin_bit_cast(u32x4, acc[ai][bj][m][0]);
                        acc[ai][bj][m][1] = (f32x4){bf_lo(r.z), bf_hi(r.z), bf_lo(r.w), bf_hi(r.w)}; acc[ai][bj][m][0] = (f32x4){bf_lo(r.x), bf_hi(r.x), bf_lo(r.y), bf_hi(r.y)}; }
        }
#pragma unroll
        for (int bj = 0; bj < 2; ++bj)
#pragma unroll
            for (int n = 0; n < 2; ++n) { const f32x4 gq = gate4(b, col0 + bj * HALF + n * 4); f32x4 rg;
#pragma unroll
                for (int j = 0; j < 4; ++j) rg[j] = 1.0f / gq[j];
#pragma unroll
                for (int ai = 0; ai < 2; ++ai)
#pragma unroll
                    for (int m = 0; m < 4; ++m) acc[ai][bj][m][n] = acc[ai][bj][m][n] * rg; }
    }
    __device__ __forceinline__ void operator()(const f32x4 (&acc)[2][2][4][2], const Unit& u, int wr, int wc, int fr, int fq) const {
        const int row0 = u.pm * BM + wr * 64 + fr, col0 = u.pn * BM + wc * 32 + 8 * fq, b = u.pm >> 3;
        f32x4 gv[2][2], av[2][2];
#pragma unroll
        for (int bj = 0; bj < 2; ++bj)
#pragma unroll
            for (int n = 0; n < 2; ++n) { gv[bj][n] = gate4(b, col0 + bj * HALF + n * 4); av[bj][n] = avec ? *(const f32x4*)(avec + (size_t)b * 12288 + col0 + bj * HALF + n * 4) : (f32x4){0.f, 0.f, 0.f, 0.f}; }
        float sq[2][4];
#pragma unroll
        for (int ai = 0; ai < 2; ++ai)
#pragma unroll
            for (int m = 0; m < 4; ++m) { const size_t ro = (size_t)(row0 + ai * HALF + m * 16) * 2048 + col0; float s = 0.f;
#pragma unroll
                for (int bj = 0; bj < 2; ++bj) { const f32x4 x0 = gv[bj][0] * acc[ai][bj][m][0], x1 = gv[bj][1] * acc[ai][bj][m][1];
                    { u32x4 wx; wx.x = cvt_pk_bf16(x0[0], x0[1]); wx.y = cvt_pk_bf16(x0[2], x0[3]); wx.z = cvt_pk_bf16(x1[0], x1[1]); wx.w = cvt_pk_bf16(x1[2], x1[3]); *(u32x4*)(xout + ro + bj * HALF) = wx; }
                    s += ((x0[0] * x0[0] + x0[1] * x0[1]) + (x0[2] * x0[2] + x0[3] * x0[3])) + ((x1[0] * x1[0] + x1[1] * x1[1]) + (x1[2] * x1[2] + x1[3] * x1[3]));
                    if (avec) { const f32x4 y0 = x0 * av[bj][0], y1 = x1 * av[bj][1]; u32x4 w; w.x = cvt_pk_bf16(y0[0], y0[1]); w.y = cvt_pk_bf16(y0[2], y0[3]); w.z = cvt_pk_bf16(y1[0], y1[1]); w.w = cvt_pk_bf16(y1[2], y1[3]);
                        *(u32x4*)(xa + ro + bj * HALF) = w; } }
                sq[ai][m] = s;
                asm volatile("" ::: "memory"); }
        const int ln_ = lane_now();
#pragma unroll
        for (int ai = 0; ai < 2; ++ai)
#pragma unroll
            for (int m = 0; m < 4; ++m) { float s = sq[ai][m]; s += wshfl_xor(s, 16, ln_); s += wshfl_xor(s, 32, ln_);
                if (fq == 0) __hip_atomic_fetch_add(ssq + row0 + ai * HALF + m * 16, ssq_fix(s), __ATOMIC_RELAXED, __HIP_MEMORY_SCOPE_AGENT); }
    }
};
struct EpiRelu2 {
    static constexpr bool PERM = true, AFTER_DRAIN = false, PRELOAD = false, MID = false, STASH = true;
    __device__ __forceinline__ Stash stash_load(const Unit& u, int t) const { Stash s; s.a = 0; s.b = 0.f; s.c = 0.f;
        if (t < 256) s.a = ssq[u.pm * BM + t]; else s.b = cmat[(size_t)(u.pm >> 3) * 8192 + u.pn * BM + (t - 256)];
        return s; }
    __device__ __forceinline__ void stash_write(const Stash& s, PG8_LAS unsigned char* slot, int t) const {
        if (t < 256) ((PG8_LAS float*)slot)[t] = __builtin_amdgcn_rsqf(ssq_val(s.a) * (1.0f / 2048.0f) + 1e-6f); else ((PG8_LAS float*)slot)[t] = s.b; }
    bf16_t* out; const ssq_t* ssq; const float* cmat;
    __device__ __forceinline__ void operator()(const f32x4 (&acc)[2][2][4][2], const Unit& u, int wr, int wc, int fr, int fq, const PG8_LAS unsigned char* slot) const {
        const int row0 = u.pm * BM + wr * 64 + fr, col0 = u.pn * BM + wc * 32 + 8 * fq;
        float rs[2][4]; stash_rows((lfp)slot, wr * 64 + fr, rs);
        store_act<4>(acc, out + (size_t)(u.pm >> 4) * (size_t)(32u << 19), 8192, row0, col0, rs, (lfp)slot + 256 + wc * 32 + 8 * fq);
    }
};

template <class Epi, class Sched, bool ALIGN_EPI = false, bool SP2 = false>
__device__ __forceinline__ void gemm_phase(PG8_LAS unsigned char* lds, const Gemm g, const Sched& S, const Epi& E) {
    int tid_ = (g.wid << 6) | lane_now(); asm volatile("" : "+v"(tid_));
    const int tid = tid_, wid = __builtin_amdgcn_readfirstlane(tid >> 6), lane = tid & 63, wr = wid >> 2, wc = wid & 3, fr = lane & 15, fq = lane >> 4;
    const int K = g.K, nt = K / BK;
    unsigned voffA[2], voffB[2];
#pragma unroll
    for (int i = 0; i < 2; ++i) { int R, C; stage_rc(tid * 16 + i * 8192, R, C); const int Rb = Epi::PERM ? ((R & ~31) + perm32(R & 31)) : R;
        voffA[i] = (unsigned)(R * K + C) * 2u; voffB[i] = (unsigned)(Rb * K + C) * 2u; }
    const size_t kstep = (size_t)(BK * 2);
    const size_t hstep = (size_t)HALF * K * 2;
    const size_t tstep = 2 * hstep;
    const unsigned ldsw = (unsigned)wid * 1024u;
    const int aoff = lds_byte(wr * 64 + fr, fq * 8), boff = lds_byte(wc * 32 + fr, fq * 8);
#define PG8_SA(b, h) (((b) * 2 + (h)) * HTB)
#define PG8_SB(b, h) ((4 + (b) * 2 + (h)) * HTB)
#define PG8_STAGE(bufoff, gbase, voff) do { _Pragma("unroll") for (int _i = 0; _i < 2; ++_i) \
        __builtin_amdgcn_global_load_lds((const unsigned*)((const char*)(gbase) + (voff)[_i]), (PG8_LAS unsigned*)(lds + (bufoff) + ldsw + _i * 8192), 16, 0, 0); } while (0)
#define PG8_LDA(dst, b, h) do { _Pragma("unroll") for (int m = 0; m < 4; ++m) _Pragma("unroll") for (int k = 0; k < 2; ++k) dst[m][k] = *(const PG8_LAS bf16x8*)(lds + PG8_SA(b, h) + aoff + m * 2048 + k * 1024); } while (0)
#define PG8_LDB(dst, b, h) do { _Pragma("unroll") for (int n = 0; n < 2; ++n) _Pragma("unroll") for (int k = 0; k < 2; ++k) dst[n][k] = *(const PG8_LAS bf16x8*)(lds + PG8_SB(b, h) + boff + n * 2048 + k * 1024); } while (0)
#define PG8_MMA(ai, bj, At, Bt) do { __builtin_amdgcn_s_setprio(1); _Pragma("unroll") for (int m = 0; m < 4; ++m) _Pragma("unroll") for (int n = 0; n < 2; ++n) _Pragma("unroll") for (int k = 0; k < 2; ++k) \
        acc[ai][bj][m][n] = __builtin_amdgcn_mfma_f32_16x16x32_bf16(Bt[n][k], At[m][k], acc[ai][bj][m][n], 0, 0, 0); __builtin_amdgcn_s_setprio(0); } while (0)
#define PG8_WAIT_V(n) asm volatile("s_waitcnt vmcnt(" #n ")" ::: "memory")
#define PG8_WAIT_L(n) asm volatile("s_waitcnt lgkmcnt(" #n ")" ::: "memory")
#define PG8_BAR __builtin_amdgcn_s_barrier()
#define PG8_SCHED __builtin_amdgcn_sched_barrier(0)
#ifdef GPROBE
    unsigned gp_ts = 0;
#define GP_PREV(k) ((GPROBE == 2) ? ((k) == 0 || (k) == 4) : ((k) == GPROBE - 1))
#define GP_MARK(k) do { if (GPROBE_EPI(Epi)) { if (GP_PREV(k)) gp_ts = (unsigned)__builtin_amdgcn_s_memrealtime(); \
        if ((k) == GPROBE) { const unsigned d_ = (unsigned)__builtin_amdgcn_s_memrealtime() - gp_ts; if (tid == 0) __hip_atomic_fetch_add((PG8_LAS unsigned*)(lds + 131072 + 320) + 32, d_, __ATOMIC_RELAXED, __HIP_MEMORY_SCOPE_WORKGROUP); } } } while (0)
#else
#define GP_MARK(k)
#endif
    Unit cur, nxt; int ui = 0;
    if (!S.next(0, cur)) return;
    f32x4 acc[2][2][4][2];
    if constexpr (Epi::PRELOAD) E.init(acc, cur, wr, wc, fr, fq);
    else {
#pragma unroll
    for (int a = 0; a < 2; ++a)
#pragma unroll
        for (int b = 0; b < 2; ++b)
#pragma unroll
            for (int m = 0; m < 4; ++m)
#pragma unroll
                for (int n = 0; n < 2; ++n) acc[a][b][m][n] = (f32x4){0.f, 0.f, 0.f, 0.f};
    }
    bf16x8 At[4][2], B0[2][2], B1[2][2];
    const char* cA = (const char*)g.A + (size_t)cur.pm * tstep + (size_t)(cur.pm >> 4) * g.agshift; const char* cB = (const char*)g.Bt + (size_t)cur.pn * tstep;
    if constexpr (Epi::STASH) { const int t_ = (wid << 6) | lane_now(); const Stash s0 = E.stash_load(cur, t_); E.stash_write(s0, lds + STASH_OFF, t_); }
    S.a_ready(cur);
    if constexpr (SP2) {
        PG8_STAGE(PG8_SB(0, 0), cB, voffB); PG8_STAGE(PG8_SB(0, 1), cB + hstep, voffB); PG8_STAGE(PG8_SA(0, 0), cA, voffA); PG8_STAGE(PG8_SA(0, 1), cA + hstep, voffA);
        if (wr == 1) PG8_BAR;
        PG8_WAIT_V(2); PG8_BAR;
        PG8_STAGE(PG8_SB(1, 0), cB + kstep, voffB); PG8_STAGE(PG8_SA(1, 0), cA + kstep, voffA); PG8_STAGE(PG8_SB(1, 1), cB + hstep + kstep, voffB);
        PG8_WAIT_V(6); PG8_BAR;
    } else {
        PG8_STAGE(PG8_SB(0, 0), cB, voffB); PG8_STAGE(PG8_SA(0, 0), cA, voffA); PG8_STAGE(PG8_SB(0, 1), cB + hstep, voffB); PG8_STAGE(PG8_SA(0, 1), cA + hstep, voffA);
        if (wr == 1) PG8_BAR;
        PG8_WAIT_V(4); PG8_BAR;
        PG8_STAGE(PG8_SB(1, 0), cB + kstep, voffB); PG8_STAGE(PG8_SA(1, 0), cA + kstep, voffA); PG8_STAGE(PG8_SB(1, 1), cB + hstep + kstep, voffB);
        PG8_WAIT_V(6); PG8_BAR;
    }
    GP_MARK(0);
    for (;;) {
        const bool has_next = S.next(ui + 1, nxt);
        const char* nA = has_next ? (const char*)g.A + (size_t)nxt.pm * tstep + (size_t)(nxt.pm >> 4) * g.agshift : cA; const char* nB = has_next ? (const char*)g.Bt + (size_t)nxt.pn * tstep : cB;
        for (int t = 0; t < nt; t += 2) {
            const bool last = (t == nt - 2);
            const char* a1 = cA + (size_t)(t + 1) * kstep;
            const char* a2 = last ? nA : cA + (size_t)(t + 2) * kstep; const char* b2 = last ? nB : cB + (size_t)(t + 2) * kstep;
            const char* a3 = a2 + kstep; const char* b3 = b2 + kstep;
            if (last && has_next) S.a_ready(nxt);
            if constexpr (Epi::MID) { if (t == (nt >> 1)) E.mid(acc, cur, wr, wc, fr, fq); }
            if constexpr (SP2) {
            PG8_LDB(B0, 0, 0); PG8_LDB(B1, 0, 1); PG8_SCHED; PG8_LDA(At, 0, 0); PG8_STAGE(PG8_SA(1, 1), a1 + hstep, voffA);
            PG8_WAIT_V(8); PG8_WAIT_L(0); PG8_BAR; PG8_MMA(0, 0, At, B0); PG8_MMA(0, 1, At, B1); PG8_BAR; PG8_SCHED;
            PG8_LDA(At, 0, 1); PG8_STAGE(PG8_SB(0, 0), b2, voffB); PG8_STAGE(PG8_SB(0, 1), b2 + hstep, voffB); PG8_STAGE(PG8_SA(0, 0), a2, voffA);
            PG8_WAIT_V(8); PG8_WAIT_L(0); PG8_BAR; PG8_MMA(1, 0, At, B0); PG8_MMA(1, 1, At, B1); PG8_BAR; PG8_SCHED;
            PG8_LDB(B0, 1, 0); PG8_LDB(B1, 1, 1); PG8_SCHED; PG8_LDA(At, 1, 0); PG8_STAGE(PG8_SA(0, 1), a2 + hstep, voffA);
            PG8_WAIT_V(8); PG8_WAIT_L(0); PG8_BAR; PG8_MMA(0, 0, At, B0); PG8_MMA(0, 1, At, B1); PG8_BAR; PG8_SCHED;
            PG8_LDA(At, 1, 1); PG8_STAGE(PG8_SB(1, 0), b3, voffB); PG8_STAGE(PG8_SB(1, 1), b3 + hstep, voffB); PG8_STAGE(PG8_SA(1, 0), a3, voffA);
            PG8_WAIT_V(8); PG8_WAIT_L(0); PG8_BAR; PG8_MMA(1, 0, At, B0); PG8_MMA(1, 1, At, B1); PG8_BAR; PG8_SCHED;
            } else {
            PG8_LDB(B0, 0, 0); PG8_SCHED; PG8_LDA(At, 0, 0); PG8_STAGE(PG8_SA(1, 1), a1 + hstep, voffA);
            PG8_WAIT_L(8); PG8_BAR; PG8_WAIT_L(0); PG8_MMA(0, 0, At, B0); PG8_BAR; PG8_SCHED;
            PG8_LDB(B1, 0, 1); PG8_STAGE(PG8_SB(0, 0), b2, voffB);
            PG8_BAR; PG8_WAIT_L(0); PG8_MMA(0, 1, At, B1); PG8_BAR;
            PG8_LDA(At, 0, 1); PG8_STAGE(PG8_SA(0, 0), a2, voffA);
            PG8_BAR; PG8_WAIT_L(0); PG8_MMA(1, 0, At, B0); PG8_BAR; PG8_SCHED;
            PG8_STAGE(PG8_SB(0, 1), b2 + hstep, voffB);
            PG8_WAIT_V(6); PG8_BAR; PG8_MMA(1, 1, At, B1); PG8_BAR;
            PG8_LDB(B0, 1, 0); PG8_SCHED; PG8_LDA(At, 1, 0); PG8_STAGE(PG8_SA(0, 1), a2 + hstep, voffA);
            PG8_WAIT_L(8); PG8_BAR; PG8_WAIT_L(0); PG8_MMA(0, 0, At, B0); PG8_BAR; PG8_SCHED;
            PG8_LDB(B1, 1, 1); PG8_STAGE(PG8_SB(1, 0), b3, voffB);
            PG8_BAR; PG8_WAIT_L(0); PG8_MMA(0, 1, At, B1); PG8_BAR;
            PG8_LDA(At, 1, 1); PG8_STAGE(PG8_SA(1, 0), a3, voffA);
            PG8_BAR; PG8_WAIT_L(0); PG8_MMA(1, 0, At, B0); PG8_BAR; PG8_SCHED;
            PG8_STAGE(PG8_SB(1, 1), b3 + hstep, voffB);
            PG8_WAIT_V(6); PG8_BAR; PG8_MMA(1, 1, At, B1); PG8_BAR;
            }
        }
        GP_MARK(2);
        if constexpr (ALIGN_EPI) { if (wr == 0) PG8_BAR; }
        if constexpr (Epi::STASH) { const int t_ = (wid << 6) | lane_now(); Stash st; if (has_next) st = E.stash_load(nxt, t_);
            E(acc, cur, wr, wc, fr, fq, lds + STASH_OFF + (ui & 1) * STASH_SLOT); if (has_next) E.stash_write(st, lds + STASH_OFF + ((ui + 1) & 1) * STASH_SLOT, t_); S.done(cur); }
        else if constexpr (!Epi::AFTER_DRAIN) { E(acc, cur, wr, wc, fr, fq); S.done(cur); }
        GP_MARK(3);
        if (!has_next) break;
        if constexpr (Epi::PRELOAD) E.init(acc, nxt, wr, wc, fr, fq);
        else {
#pragma unroll
        for (int a = 0; a < 2; ++a)
#pragma unroll
            for (int b = 0; b < 2; ++b)
#pragma unroll
                for (int m = 0; m < 4; ++m)
#pragma unroll
                    for (int n = 0; n < 2; ++n) acc[a][b][m][n] = (f32x4){0.f, 0.f, 0.f, 0.f};
        }
        cur = nxt; cA = nA; cB = nB; ++ui;
        if constexpr (ALIGN_EPI) { if (wr == 1) PG8_BAR; }
        GP_MARK(4);
    }
    PG8_WAIT_V(0);
    if constexpr (!ALIGN_EPI) { if (wr == 0) PG8_BAR; }
    PG8_BAR;
    if constexpr (Epi::AFTER_DRAIN) { E.fused(acc, cur, wr, wc, fr, fq, lds, wid, lane); S.done(cur); }
#undef PG8_SA
#undef PG8_SB
#undef PG8_STAGE
#undef PG8_LDA
#undef PG8_LDB
#undef PG8_MMA
#undef PG8_WAIT_V
#undef PG8_WAIT_L
#undef PG8_BAR
#undef PG8_SCHED
}
}

constexpr int NWAVES = 8;
constexpr int BATCH = 16, SEQ = 2048, D = 2048, DEPTH = 4, AW = 1024, INW = 10240, FF = 8192, NMODC = 6 * D;
constexpr int M = BATCH * SEQ;
constexpr float EPS = 1e-6f;
#ifndef MK_SINGLE
#define MK_SINGLE 1
#endif
constexpr int N_PHASES = 4 + 6 * DEPTH + 1;

constexpr size_t MiB = 1u << 20;
constexpr size_t WS_CTL = 0, CTL_ZERO_BYTES = 8 * MiB;
constexpr size_t WS_MOD = 1 * MiB;
constexpr size_t WS_LB = 4 * MiB;
constexpr size_t WS_SSQ = 5 * MiB;
constexpr size_t WS_W = 8 * MiB, W_LAYER = 120 * MiB;
constexpr size_t WO_IN = 0, WO_A = 40 * MiB, WO_B = 44 * MiB, WO_OUT = 48 * MiB, WO_F1 = 56 * MiB, WO_F2 = 88 * MiB;
constexpr size_t WS_ACT = WS_W + DEPTH * W_LAYER;
constexpr size_t WS_OG = WS_ACT + 128 * MiB;
constexpr size_t WS_SG = WS_OG + 8 * MiB;
constexpr size_t WS_PROJ = WS_OG + 128 * MiB;
constexpr size_t WS_Q = WS_PROJ, WS_K = WS_Q + 8 * MiB, WS_LF = WS_K + 8 * MiB, WS_V = WS_LF + 16 * MiB, WS_G = WS_V + 8 * MiB, WS_U = WS_G + 8 * MiB, WS_VG = WS_U + 8 * MiB, WS_GA = WS_VG + 8 * MiB, WS_GB = WS_GA + 16 * MiB;
constexpr size_t GS_P2 = 88 * MiB  , GS_P4 = 80 * MiB  , GS_HID = 32 * MiB  , GS_OG = 8 * MiB  ;
constexpr size_t WS_C1 = WS_PROJ + 768 * MiB  , WS_C2 = WS_C1 + 3 * MiB  , WS_END = WS_C2 + 2 * MiB;
constexpr size_t WS_HID = WS_PROJ;
constexpr size_t WS_MODP = WS_PROJ;
static_assert(WS_PROJ + 768 * MiB <= WS_C1 && WS_MOD + (size_t)DEPTH * BATCH * NMODC * 4 <= WS_LB && WS_SSQ + (size_t)(2 * DEPTH + 1) * M * 8 <= CTL_ZERO_BYTES && CTL_ZERO_BYTES <= WS_W && (size_t)DEPTH * BATCH * INW * 4 <= 3 * MiB && (size_t)DEPTH * BATCH * FF * 4 <= 2 * MiB, "d_ws map");
constexpr int CW_BAR = 4096;
constexpr int CW_GBAR = 16384;

constexpr int RING_OFF = 0, RING_BYTES = 131072;
constexpr int LDSCTL_OFF = RING_BYTES, MISC_OFF = LDSCTL_OFF + 320;
constexpr int LDS_BYTES = 147456;

#define GAS __attribute__((address_space(1)))
#define LAS __attribute__((address_space(3)))
typedef unsigned short bf16;
typedef unsigned v4u __attribute__((ext_vector_type(4)));
typedef unsigned v2u __attribute__((ext_vector_type(2)));
typedef float f32x4 __attribute__((ext_vector_type(4)));
typedef short bf16x8 __attribute__((ext_vector_type(8)));
typedef short s16x4 __attribute__((ext_vector_type(4)));
typedef GAS unsigned gu32;
#define RLX_AGENT __ATOMIC_RELAXED, __HIP_MEMORY_SCOPE_AGENT
#define LDS_WAIT() asm volatile("s_waitcnt lgkmcnt(0)" ::: "memory")
#define VM_WAIT() asm volatile("s_waitcnt vmcnt(0)" ::: "memory")
__device__ __forceinline__ unsigned f2bf(float f) { return (unsigned)__builtin_bit_cast(unsigned short, (__bf16)f); }
__device__ __forceinline__ unsigned pk2(float lo, float hi) { return pg8::cvt_pk_bf16(lo, hi); }
__device__ __forceinline__ float bflo(unsigned w) { return __uint_as_float(w << 16); }
__device__ __forceinline__ float bfhi(unsigned w) { return __uint_as_float(w & 0xffff0000u); }
__device__ __forceinline__ float bf1(bf16 h) { return __uint_as_float(((unsigned)h) << 16); }
__device__ __forceinline__ float wave_sum(float v) {
    v += __builtin_bit_cast(float, __builtin_amdgcn_update_dpp(0, __builtin_bit_cast(int, v), 0x128, 0xf, 0xf, false));
    v += __builtin_bit_cast(float, __builtin_amdgcn_update_dpp(0, __builtin_bit_cast(int, v), 0x124, 0xf, 0xf, false));
    v += __builtin_bit_cast(float, __builtin_amdgcn_update_dpp(0, __builtin_bit_cast(int, v), 0x122, 0xf, 0xf, false));
    v += __builtin_bit_cast(float, __builtin_amdgcn_update_dpp(0, __builtin_bit_cast(int, v), 0x121, 0xf, 0xf, false));
    const int i_ = __builtin_bit_cast(int, v);
    return (__builtin_bit_cast(float, __builtin_amdgcn_readlane(i_, 0)) + __builtin_bit_cast(float, __builtin_amdgcn_readlane(i_, 16))) + (__builtin_bit_cast(float, __builtin_amdgcn_readlane(i_, 32)) + __builtin_bit_cast(float, __builtin_amdgcn_readlane(i_, 48)));
}

#define XB_TMO      128
#define XB_XCNT(j)  (256  + 64 * (j))
#define XB_XSUB(j)  (1280 + 64 * (j))
#define XB_XGEN(j)  (2304 + 64 * (j))
#define XB_TOP      3328
#define XB_TOPGEN   3392
#define XCD_BAR_WORDS 3456
#define XB_SPIN_CAP (1u << 18)

__device__ __forceinline__ unsigned xb_ld(unsigned* p)              { return __hip_atomic_load(p, __ATOMIC_RELAXED, __HIP_MEMORY_SCOPE_AGENT); }
__device__ __forceinline__ unsigned xb_add(unsigned* p, unsigned v) { return __hip_atomic_fetch_add(p, v, __ATOMIC_RELAXED, __HIP_MEMORY_SCOPE_AGENT); }
__device__ __forceinline__ unsigned xb_xcc_id() { return (unsigned)__builtin_amdgcn_s_getreg((3 << 11) | 20) & 0xFu; }
#define XB_SPIN(cond, bar) do { unsigned _sp = 0; while (cond) { __builtin_amdgcn_s_sleep(1); \
    if ((++_sp & 255u) == 0u) { if (xb_ld(&(bar)[XB_TMO])) break; if (_sp > XB_SPIN_CAP) { atomicAdd(&(bar)[XB_TMO], 1u); break; } } } } while (0)

struct XcdBarrier {
    unsigned* bar; unsigned x; unsigned total;
    volatile LAS unsigned* st;
};

__device__ __forceinline__ XcdBarrier xcd_barrier_post(unsigned* bar, volatile LAS unsigned* st, unsigned total) {
    XcdBarrier b; b.bar = bar; b.x = xb_xcc_id(); b.st = st; b.total = total;
    if (threadIdx.x == 0) (void)xb_add(&bar[XB_XCNT(b.x)], 1u);
    return b;
}
__device__ __forceinline__ void xcd_barrier_complete(unsigned* bar, unsigned x, unsigned& nloc, unsigned& nx, const unsigned G) {
    unsigned sum, cnt, mine, sp = 0u;
    for (;;) {
        sum = 0u; cnt = 0u; mine = 0u;
#pragma unroll
        for (unsigned j = 0; j < 16; ++j) { const unsigned c = xb_ld(&bar[XB_XCNT(j)]); sum += c; cnt += (c > 0u) ? 1u : 0u; mine = (j == x) ? c : mine; }
        if (sum == G) break;
        __builtin_amdgcn_s_sleep(1);
        if ((++sp & 255u) == 0u) { if (xb_ld(&bar[XB_TMO])) break; if (sp > XB_SPIN_CAP) { atomicAdd(&bar[XB_TMO], 1u); break; } }
    }
    nloc = mine > 0u ? mine : 1u; nx = cnt > 0u ? cnt : 1u;
}

__device__ __forceinline__ void xcd_barrier(const XcdBarrier& b) {
    asm volatile("s_waitcnt vmcnt(0)" ::: "memory");
    __syncthreads();
    if (threadIdx.x == 0) {
        unsigned* bar = b.bar;
        __builtin_amdgcn_s_waitcnt(0);
        unsigned nloc = b.st[0], nx = b.st[1];
        if (nloc == 0u) { xcd_barrier_complete(bar, b.x, nloc, nx, b.total); b.st[0] = nloc; b.st[1] = nx; }
        const unsigned old = xb_add(&bar[XB_XSUB(b.x)], 1u);
        const unsigned gen = old / nloc;
        if (old + 1u == (gen + 1u) * nloc) {
            __builtin_amdgcn_fence(__ATOMIC_RELEASE, "agent");
            asm volatile("s_waitcnt vmcnt(0)" ::: "memory");
            const unsigned og = xb_add(&bar[XB_TOP], 1u);
            const unsigned tg = og / nx;
            if (og + 1u == (tg + 1u) * nx) xb_add(&bar[XB_TOPGEN], 1u);
            else XB_SPIN(xb_ld(&bar[XB_TOPGEN]) == tg, bar);
            __builtin_amdgcn_fence(__ATOMIC_ACQUIRE, "agent");
            xb_add(&bar[XB_XGEN(b.x)], 1u);
            asm volatile("s_waitcnt vmcnt(0)" ::: "memory");
        } else {
            XB_SPIN(xb_ld(&bar[XB_XGEN(b.x)]) == gen, bar);
            __builtin_amdgcn_fence(__ATOMIC_ACQUIRE, "agent");
            asm volatile("s_waitcnt vmcnt(0)" ::: "memory");
        }
    }
    __syncthreads();
}

struct Frame {
    LAS unsigned char* lds;
    volatile LAS unsigned* MISC;
    gu32* ctl;
    int tid, lane, wave;
    int G, bid;
    unsigned char* ws;
    const float* const* in;
    float* out;
};

__device__ __forceinline__ void p0_transpose_item(const float* W, int K, int N, bf16* WT, int ldk, int koff, bool ilv, LAS float* scr, int item, int lane) {
    const int nblk = N / 32, kb = item / nblk, nb = item % nblk, k0 = 64 * kb, n0 = 32 * nb;
    int dn0 = n0;
    if (ilv && n0 >= 6144) { const int c = (n0 - 6144) & 2047, second = (n0 >= 8192) ? 128 : 0; dn0 = 6144 + 256 * (c >> 7) + second + (c & 127); }
#pragma unroll 8
    for (int i = 0; i < 32; ++i) { const int kk = 2 * i + (lane >> 5); scr[kk * 33 + (lane & 31)] = W[(size_t)(k0 + kk) * N + n0 + (lane & 31)]; }
    LDS_WAIT(); asm volatile("" ::: "memory");
    const int c = lane & 7;
#pragma unroll
    for (int j = 0; j < 4; ++j) { const int n = (lane >> 3) + 8 * j; const LAS float* s = scr + (8 * c) * 33 + n;
        v4u o; o.x = pk2(s[0 * 33], s[1 * 33]); o.y = pk2(s[2 * 33], s[3 * 33]); o.z = pk2(s[4 * 33], s[5 * 33]); o.w = pk2(s[6 * 33], s[7 * 33]);
        *(GAS v4u*)(WT + (size_t)(dn0 + n) * ldk + koff + k0 + 8 * c) = o; }
    LDS_WAIT(); asm volatile("" ::: "memory");
}
__device__ __forceinline__ void p0_mod_item(Frame& F, int item, LAS float* cT) {
    const int ks = item & 7, cb = (item >> 3) % 48, l = item / 384, k0 = 256 * ks, lane = F.lane;
    const float* c = F.in[1]; const float* W = F.in[2] + (size_t)l * D * NMODC;
    for (int idx = lane; idx < 4096; idx += 64) { const int kk = idx & 255, b = idx >> 8; const float x = c[b * D + k0 + kk]; cT[kk * 16 + b] = x * __builtin_amdgcn_rcpf(1.0f + __builtin_amdgcn_exp2f(-1.44269504089f * x)); }
    LDS_WAIT(); asm volatile("" ::: "memory");
    f32x4 acc[16];
#pragma unroll
    for (int b = 0; b < 16; ++b) acc[b] = (f32x4){0.f, 0.f, 0.f, 0.f};
    const float* wp = W + (size_t)k0 * NMODC + cb * 256 + 4 * lane;
#pragma unroll 4
    for (int kk = 0; kk < 256; ++kk) {
        const f32x4 w4 = *(const GAS f32x4*)(wp + (size_t)kk * NMODC);
        const LAS f32x4* cr = (const LAS f32x4*)(cT + kk * 16);
#pragma unroll
        for (int q = 0; q < 4; ++q) { const f32x4 cv = cr[q];
            acc[4 * q + 0] += w4 * cv.x; acc[4 * q + 1] += w4 * cv.y; acc[4 * q + 2] += w4 * cv.z; acc[4 * q + 3] += w4 * cv.w; }
    }
    float* o = (float*)(F.ws + WS_MODP) + ((size_t)(l * 8 + ks) * BATCH) * NMODC + cb * 256 + 4 * lane;
#pragma unroll
    for (int b = 0; b < 16; ++b) *(GAS f32x4*)(o + (size_t)b * NMODC) = acc[b];
    LDS_WAIT(); asm volatile("" ::: "memory");
}
__device__ __forceinline__ void p0a(Frame& F) {
    LAS float* scr = (LAS float*)(F.lds + RING_OFF + F.wave * 16384);
    const int gw = F.bid * NWAVES + F.wave, NGW = F.G * NWAVES;
    for (int it = gw; it < DEPTH * 48 * 8; it += NGW) p0_mod_item(F, it, scr);
    constexpr int I_IN = (D / 64) * (INW / 32), I_A = (AW / 64) * (D / 32), I_O = (D / 64) * (D / 32), I_F1 = (D / 64) * (FF / 32), I_F2 = (FF / 64) * (D / 32);
    constexpr int I_LAYER = I_IN + 2 * I_A + I_O + I_F1 + I_F2;
    for (int it = gw; it < DEPTH * I_LAYER; it += NGW) {
        const int l = it / I_LAYER; int r = it % I_LAYER; unsigned char* wl = F.ws + WS_W + (size_t)l * W_LAYER;
        if (r < I_IN) { p0_transpose_item(F.in[6] + (size_t)l * D * INW, D, INW, (bf16*)(wl + WO_IN), D, 0, true, scr, r, F.lane); continue; } r -= I_IN;
        if (r < I_A) { p0_transpose_item(F.in[13] + (size_t)l * AW * D, AW, D, (bf16*)(wl + WO_A), 2 * AW, 0, false, scr, r, F.lane); continue; } r -= I_A;
        if (r < I_A) { p0_transpose_item(F.in[14] + (size_t)l * AW * D, AW, D, (bf16*)(wl + WO_A), 2 * AW, AW, false, scr, r, F.lane); continue; } r -= I_A;
        if (r < I_O) { p0_transpose_item(F.in[15] + (size_t)l * D * D, D, D, (bf16*)(wl + WO_OUT), D, 0, false, scr, r, F.lane); continue; } r -= I_O;
        if (r < I_F1) { p0_transpose_item(F.in[16] + (size_t)l * D * FF, D, FF, (bf16*)(wl + WO_F1), D, 0, false, scr, r, F.lane); continue; } r -= I_F1;
        p0_transpose_item(F.in[17] + (size_t)l * FF * D, FF, D, (bf16*)(wl + WO_F2), FF, 0, false, scr, r, F.lane);
    }
}
__device__ __forceinline__ void p0b(Frame& F) {
    const int gt = F.bid * (NWAVES * 64) + F.tid, NT = F.G * NWAVES * 64;
    const float* P = (const float*)(F.ws + WS_MODP); float* MOD = (float*)(F.ws + WS_MOD);
    for (int i = gt; i < DEPTH * BATCH * NMODC; i += NT) {
        const int j = i % NMODC, b = (i / NMODC) % BATCH, l = i / (NMODC * BATCH);
        float s = F.in[3][l * NMODC + j];
#pragma unroll
        for (int ks = 0; ks < 8; ++ks) s += P[((size_t)(l * 8 + ks) * BATCH + b) * NMODC + j];
        const int sec = j / D, col = j % D;
        if (sec == 1) s = F.in[4][l * D + col] * (1.0f + s);
        if (sec == 4) s = F.in[5][l * D + col] * (1.0f + s);
        MOD[i] = s;
    }
    float* LB = (float*)(F.ws + WS_LB);
    for (int k = gt; k < AW; k += NT) {
        float v[DEPTH], mx = -3.0e38f;
#pragma unroll
        for (int l = 0; l < DEPTH; ++l) { v[l] = F.in[7][l * AW + k]; mx = fmaxf(mx, v[l]); }
        float sum = 0.f;
#pragma unroll
        for (int l = 0; l < DEPTH; ++l) { v[l] = __expf(v[l] - mx); sum += v[l]; }
        const float inv = 1.0f / sum; float cum = 0.f;
#pragma unroll
        for (int l = 0; l < DEPTH; ++l) { cum += v[l] * inv; LB[l * AW + k] = cum - v[0] * inv; }
    }
}
__device__ __forceinline__ void p0c(Frame& F) {
    const int gw = F.bid * NWAVES + F.wave, NGW = F.G * NWAVES, fr = F.lane & 15, fq = F.lane >> 4;
    constexpr int T1 = INW / 16, T2 = FF / 16, TL = T1 + T2;
    for (int it = gw; it < DEPTH * TL; it += NGW) {
        const int l = it / TL, r = it % TL; const bool second = r >= T1; const int n0 = 16 * (second ? r - T1 : r), N = second ? FF : INW;
        const bf16* Wt = (const bf16*)(F.ws + WS_W + (size_t)l * W_LAYER + (second ? WO_F1 : WO_IN)) + (size_t)(n0 + fr) * D + 8 * fq;
        const float* sh = (const float*)(F.ws + WS_MOD) + ((size_t)l * BATCH + fr) * NMODC + (second ? 3 * D : 0) + 8 * fq;
        f32x4 acc = {0.f, 0.f, 0.f, 0.f};
#pragma unroll 8
        for (int ks = 0; ks < D / 32; ++ks) {
            const v4u a = *(const GAS v4u*)(Wt + 32 * ks); const f32x4 s0 = *(const GAS f32x4*)(sh + 32 * ks), s1 = *(const GAS f32x4*)(sh + 32 * ks + 4);
            v4u bq; bq.x = pk2(s0.x, s0.y); bq.y = pk2(s0.z, s0.w); bq.z = pk2(s1.x, s1.y); bq.w = pk2(s1.z, s1.w);
            acc = __builtin_amdgcn_mfma_f32_16x16x32_bf16(__builtin_bit_cast(bf16x8, a), __builtin_bit_cast(bf16x8, bq), acc, 0, 0, 0);
        }
        float* C = (float*)(F.ws + (second ? WS_C2 : WS_C1)) + ((size_t)l * BATCH + fr) * N + n0 + 4 * fq;
        *(GAS f32x4*)C = acc;
    }
}
__device__ __forceinline__ void prep_phase(Frame& F, const float* x, bf16* xa, const float* a, pg8::ssq_t* ssq) {
    const int gw = F.bid * NWAVES + F.wave, NGW = F.G * NWAVES;
    for (int m = gw; m < M; m += NGW) {
        const GAS f32x4* xr = (const GAS f32x4*)(x + (size_t)m * D) + F.lane; const int b = m / SEQ;
        const GAS f32x4* ar = (const GAS f32x4*)(a + (size_t)b * NMODC) + F.lane; GAS v2u* o = (GAS v2u*)(xa + (size_t)m * D) + F.lane;
        float s = 0.f;
#pragma unroll
        for (int j = 0; j < 8; ++j) { const f32x4 v = xr[64 * j], av = ar[64 * j]; s += (v.x * v.x + v.y * v.y) + (v.z * v.z + v.w * v.w); const f32x4 y = v * av; v2u w; w.x = pk2(y.x, y.y); w.y = pk2(y.z, y.w); o[64 * j] = w; }
        s = wave_sum(s);
        if (F.lane == 0) ssq[m] = pg8::ssq_fix(s);
    }
}
__device__ __forceinline__ void final_norm_phase(Frame& F, const bf16* x, float* out, const float* g, const pg8::ssq_t* ssq, int row0, int nrows, int wv, int nwv, float oscale) {
    for (int m = row0 + wv; m < row0 + nrows; m += nwv) {
        const GAS v4u* xr = (const GAS v4u*)(x + (size_t)m * D) + F.lane;
        const float rstd = oscale / sqrtf(pg8::ssq_val(__hip_atomic_load(ssq + m, __ATOMIC_RELAXED, __HIP_MEMORY_SCOPE_AGENT)) * (1.f / D) + EPS);
        const GAS f32x4* gr = (const GAS f32x4*)g + 2 * F.lane; GAS f32x4* o = (GAS f32x4*)(out + (size_t)m * D) + 2 * F.lane;
#pragma unroll
        for (int j = 0; j < 4; ++j) { const v4u r = xr[64 * j];
            o[128 * j] = (f32x4){bflo(r.x), bfhi(r.x), bflo(r.y), bfhi(r.y)} * rstd * gr[128 * j]; o[128 * j + 1] = (f32x4){bflo(r.z), bfhi(r.z), bflo(r.w), bfhi(r.w)} * rstd * gr[128 * j + 1]; }
    }
}
constexpr int SG_VP = 288, SG_TILE = 128 * SG_VP, SG_STAT = 2 * SG_TILE;
__device__ __forceinline__ void sgu_unit(Frame& F, int bn, const float* lng, const float* lnb, const float* wsp, const float* bsp) {
    const int tid = F.tid, lane = F.lane, wave = F.wave, fr = lane & 15, fq = lane >> 4; const size_t r0 = (size_t)bn * 128;
    LAS unsigned char* L = F.lds + RING_OFF;
    LAS float* st_r = (LAS float*)(L + SG_STAT); LAS float* st_m = st_r + 128;
    const size_t grp_ = (size_t)(bn >> 5);
    const bf16* Vg = (const bf16*)(F.ws + WS_VG + grp_ * GS_P2); const bf16* Ub = (const bf16*)(F.ws + WS_U + grp_ * GS_P2); bf16* SG = (bf16*)(F.ws + WS_OG) + AW;
    const int ls = tid >> 2, ld0 = (tid & 3) * 32;
    v4u vt[4];
#pragma unroll
    for (int i = 0; i < 4; ++i) vt[i] = *(const GAS v4u*)(Vg + (r0 + ls) * AW + ld0 + 8 * i);
    __syncthreads();
#pragma unroll
    for (int hb = 0; hb < 2; ++hb) { v4u a[8], c[8];
#pragma unroll
        for (int i = 0; i < 8; ++i) { const bf16* vr = Vg + (r0 + 16 * wave + 8 * hb + i) * AW; a[i] = *(const GAS v4u*)(vr + 8 * lane); c[i] = *(const GAS v4u*)(vr + 512 + 8 * lane); }
#pragma unroll
        for (int i = 0; i < 8; ++i) {
            const float x[16] = {bflo(a[i].x), bfhi(a[i].x), bflo(a[i].y), bfhi(a[i].y), bflo(a[i].z), bfhi(a[i].z), bflo(a[i].w), bfhi(a[i].w), bflo(c[i].x), bfhi(c[i].x), bflo(c[i].y), bfhi(c[i].y), bflo(c[i].z), bfhi(c[i].z), bflo(c[i].w), bfhi(c[i].w)};
            float s = 0.f;
#pragma unroll
            for (int j = 0; j < 16; ++j) s += x[j];
            const float mean = wave_sum(s) * (1.f / 1024.f); float q = 0.f;
#pragma unroll
            for (int j = 0; j < 16; ++j) { const float d = x[j] - mean; q += d * d; }
            const float rstd = 1.0f / sqrtf(wave_sum(q) * (1.f / 1024.f) + EPS);
            if (lane == 0) { st_r[16 * wave + 8 * hb + i] = rstd; st_m[16 * wave + 8 * hb + i] = mean; } } }
    const int t = 16 * wave + fr, kmax = wave >> 1;
    for (int g = 0; g < 8; ++g) {
        LAS unsigned char* Lt = L + (g & 1) * SG_TILE;
#pragma unroll
        for (int i = 0; i < 4; ++i) *(LAS v4u*)(Lt + ls * SG_VP + 2 * (ld0 + 8 * i)) = vt[i];
        if (g + 1 < 8) {
#pragma unroll
            for (int i = 0; i < 4; ++i) vt[i] = *(const GAS v4u*)(Vg + (r0 + ls) * AW + (g + 1) * 128 + ld0 + 8 * i); }
        v2u u8[8]; const bf16* up = Ub + (r0 + t) * AW + g * 128 + 4 * fq;
#pragma unroll
        for (int dt = 0; dt < 8; ++dt) u8[dt] = *(const GAS v2u*)(up + 16 * dt);
        const float bs = bsp[g * 128 + t];
        __syncthreads();
        f32x4 acc[8];
#pragma unroll
        for (int dt = 0; dt < 8; ++dt) acc[dt] = (f32x4){0.f, 0.f, 0.f, 0.f};
        float c1 = 0.f, c2 = 0.f; const float* wrow = wsp + ((size_t)g * 128 + t) * 128;
        for (int ks = 0; ks <= kmax; ++ks) { const int s0 = 32 * ks + 8 * fq;
            const f32x4 w0 = *(const GAS f32x4*)(wrow + s0), w1 = *(const GAS f32x4*)(wrow + s0 + 4);
            const f32x4 r0v = *(const LAS f32x4*)(st_r + s0), r1v = *(const LAS f32x4*)(st_r + s0 + 4), m0v = *(const LAS f32x4*)(st_m + s0), m1v = *(const LAS f32x4*)(st_m + s0 + 4);
            const float wv[8] = {w0.x, w0.y, w0.z, w0.w, w1.x, w1.y, w1.z, w1.w}, rv[8] = {r0v.x, r0v.y, r0v.z, r0v.w, r1v.x, r1v.y, r1v.z, r1v.w}, mv[8] = {m0v.x, m0v.y, m0v.z, m0v.w, m1v.x, m1v.y, m1v.z, m1v.w};
            float wp[8];
#pragma unroll
            for (int e = 0; e < 8; ++e) { const float wm = (s0 + e <= t) ? wv[e] : 0.f; wp[e] = wm * rv[e]; c1 += wp[e] * mv[e]; c2 += wm; }
            v4u bq; bq.x = pk2(wp[0], wp[1]); bq.y = pk2(wp[2], wp[3]); bq.z = pk2(wp[4], wp[5]); bq.w = pk2(wp[6], wp[7]);
            const LAS unsigned char* ap = Lt + (32 * ks + 8 * fq + (fr >> 2)) * SG_VP + 8 * (fr & 3);
#pragma unroll
            for (int dt = 0; dt < 8; ++dt) { const s16x4 a0 = __builtin_amdgcn_ds_read_tr16_b64_v4i16((LAS s16x4*)(ap + 32 * dt)), a1 = __builtin_amdgcn_ds_read_tr16_b64_v4i16((LAS s16x4*)(ap + 32 * dt + 4 * SG_VP));
                acc[dt] = __builtin_amdgcn_mfma_f32_16x16x32_bf16((bf16x8){a0.x, a0.y, a0.z, a0.w, a1.x, a1.y, a1.z, a1.w}, __builtin_bit_cast(bf16x8, bq), acc[dt], 0, 0, 0); } }
        { const int l_ = pg8::lane_now(); c1 += pg8::wshfl_xor(c1, 16, l_); c1 += pg8::wshfl_xor(c1, 32, l_); c2 += pg8::wshfl_xor(c2, 16, l_); c2 += pg8::wshfl_xor(c2, 32, l_); }
        bf16* op = SG + (r0 + t) * (2 * AW) + g * 128 + 4 * fq;
#pragma unroll
        for (int dt = 0; dt < 8; ++dt) { const f32x4 lg = *(const GAS f32x4*)(lng + g * 128 + 16 * dt + 4 * fq), lb = *(const GAS f32x4*)(lnb + g * 128 + 16 * dt + 4 * fq);
            const f32x4 uu = {bflo(u8[dt].x), bfhi(u8[dt].x), bflo(u8[dt].y), bfhi(u8[dt].y)};
            const f32x4 o = uu * (lg * (acc[dt] - c1) + lb * c2 + bs);
            v2u wq; wq.x = pk2(o.x, o.y); wq.y = pk2(o.z, o.w); *(GAS v2u*)(op + 16 * dt) = wq; }
    }
    __syncthreads();
}

constexpr int HG_QT = 0, HG_KT = 8704, HG_KH = 17408, HG_VV = 26624, HG_EBL = 35840, HG_BUF = 36864  , HG_OS = 73728, HG_OSB = 16896  , HG_PS = 107520  ;
constexpr int HG_QP = 272, HG_KP = 288, HG_OP = 132;
struct HgIn { f32x4 lf0, lf1, bl0, bl1; v4u q8, k8, v8, g8; };
__device__ __forceinline__ void hg_load(HgIn& r, const float* LF, const bf16* Qb, const bf16* Kb, const bf16* Vb, const bf16* Gb, size_t go, size_t gl) {
    r.lf0 = *(const GAS f32x4*)(LF + go); r.lf1 = *(const GAS f32x4*)(LF + go + 4); r.bl0 = *(const GAS f32x4*)(LF + gl); r.bl1 = *(const GAS f32x4*)(LF + gl + 4);
    r.q8 = *(const GAS v4u*)(Qb + go); r.k8 = *(const GAS v4u*)(Kb + go); r.v8 = *(const GAS v4u*)(Vb + go); r.g8 = *(const GAS v4u*)(Gb + go);
}
__device__ __forceinline__ bf16x8 hg_frag64x2(const LAS unsigned char* p) {
    const v2u a = *(const LAS v2u*)p, b = *(const LAS v2u*)(p + 32); const v4u r = {a.x, a.y, b.x, b.y}; return __builtin_bit_cast(bf16x8, r);
}
__device__ __forceinline__ bf16x8 hg_frag_tr(const LAS unsigned char* p) {
    const s16x4 a = __builtin_amdgcn_ds_read_tr16_b64_v4i16((LAS s16x4*)p), b = __builtin_amdgcn_ds_read_tr16_b64_v4i16((LAS s16x4*)(p + 16 * HG_KP));
    return (bf16x8){a.x, a.y, a.z, a.w, b.x, b.y, b.z, b.w};
}
__device__ __forceinline__ void hg_epilogue(LAS unsigned char* Los, int et, int ko, const float (&ng8)[8], const v4u g8, bf16* dst) {
    const LAS float* orow = (const LAS float*)Los + et * HG_OP + 8 * ko;
    const f32x4 o0 = *(const LAS f32x4*)orow, o1 = *(const LAS f32x4*)(orow + 4);
    float ss = (o0.x * o0.x + o0.y * o0.y) + (o0.z * o0.z + o0.w * o0.w) + (o1.x * o1.x + o1.y * o1.y) + (o1.z * o1.z + o1.w * o1.w);
    ss += __builtin_bit_cast(float, __builtin_amdgcn_update_dpp(0, __builtin_bit_cast(int, ss), 0x128, 0xf, 0xf, false));
    ss += __builtin_bit_cast(float, __builtin_amdgcn_update_dpp(0, __builtin_bit_cast(int, ss), 0x124, 0xf, 0xf, false));
    ss += __builtin_bit_cast(float, __builtin_amdgcn_update_dpp(0, __builtin_bit_cast(int, ss), 0x122, 0xf, 0xf, false));
    ss += __builtin_bit_cast(float, __builtin_amdgcn_update_dpp(0, __builtin_bit_cast(int, ss), 0x121, 0xf, 0xf, false));
    const float rstd = __builtin_amdgcn_rsqf(ss * (1.f / 128.f) + EPS);
    v4u w;
    w.x = pk2(o0.x * rstd * ng8[0] * bflo(g8.x), o0.y * rstd * ng8[1] * bfhi(g8.x)); w.y = pk2(o0.z * rstd * ng8[2] * bflo(g8.y), o0.w * rstd * ng8[3] * bfhi(g8.y));
    w.z = pk2(o1.x * rstd * ng8[4] * bflo(g8.z), o1.y * rstd * ng8[5] * bfhi(g8.z)); w.w = pk2(o1.z * rstd * ng8[6] * bflo(g8.w), o1.w * rstd * ng8[7] * bfhi(g8.w));
    *(GAS v4u*)dst = w;
}
__device__ __forceinline__ void hgrn_unit_mfma(Frame& F, int bh, const float* ng) {
    const int b = bh >> 3, h = bh & 7, tid = F.tid, lane = F.lane, w = F.wave;
    const int et = tid >> 4, ko = tid & 15, fr = lane & 15, fq = lane >> 4;
    LAS unsigned char* L = F.lds + RING_OFF;
    const size_t gp2 = (size_t)(b >> 1) * GS_P2, gp4 = (size_t)(b >> 1) * GS_P4, oo0 = ((size_t)b * SEQ + (tid >> 4)) * (2 * AW) + h * 128 + 8 * (tid & 15);
    const bf16* Qb = (const bf16*)(F.ws + WS_Q + gp2); const bf16* Kb = (const bf16*)(F.ws + WS_K + gp2); const bf16* Vb = (const bf16*)(F.ws + WS_V + gp2); const bf16* Gb = (const bf16*)(F.ws + WS_G + gp2);
    const float* LF = (const float*)(F.ws + WS_LF + gp4); bf16* OG = (bf16*)(F.ws + WS_OG);
    const size_t go0 = ((size_t)b * SEQ + et) * AW + h * 128 + 8 * ko;
    float ng8[8];
#pragma unroll
    for (int j = 0; j < 8; ++j) ng8[j] = ng[8 * ko + j];
    f32x4 S[8];
#pragma unroll
    for (int T = 0; T < 8; ++T) S[T] = (f32x4){0.f, 0.f, 0.f, 0.f};
    const size_t gl0 = ((size_t)b * SEQ + 31) * AW + h * 128 + 8 * ko;
    HgIn cur, nxt; hg_load(cur, LF, Qb, Kb, Vb, Gb, go0, gl0); hg_load(nxt, LF, Qb, Kb, Vb, Gb, go0 + (size_t)32 * AW, gl0 + (size_t)32 * AW);
    v4u gprev = {0u, 0u, 0u, 0u};
    __syncthreads();
    for (int c2 = 0; c2 < SEQ / 32; c2 += 2) {
#pragma unroll
      for (int h = 0; h < 2; ++h) {
        HgIn& R = h ? nxt : cur; const int c = c2 + h;
        LAS unsigned char* Lb = L + (c & 1) * HG_BUF;
        LAS unsigned char* Lo = L + HG_OS + (c & 1) * HG_OSB;
        { const float bc[8] = {R.lf0.x, R.lf0.y, R.lf0.z, R.lf0.w, R.lf1.x, R.lf1.y, R.lf1.z, R.lf1.w};
          const float bl[8] = {R.bl0.x, R.bl0.y, R.bl0.z, R.bl0.w, R.bl1.x, R.bl1.y, R.bl1.z, R.bl1.w};
          const float qf[8] = {bflo(R.q8.x), bfhi(R.q8.x), bflo(R.q8.y), bfhi(R.q8.y), bflo(R.q8.z), bfhi(R.q8.z), bflo(R.q8.w), bfhi(R.q8.w)};
          const float kf[8] = {bflo(R.k8.x), bfhi(R.k8.x), bflo(R.k8.y), bfhi(R.k8.y), bflo(R.k8.z), bfhi(R.k8.z), bflo(R.k8.w), bfhi(R.k8.w)};
          float qt[8], kt[8], kh[8];
#pragma unroll
          for (int j = 0; j < 8; ++j) { const float bj = bc[j]; qt[j] = qf[j] * __expf(bj); kt[j] = kf[j] * __expf(fminf(-bj, 80.f)); kh[j] = kf[j] * __expf(bl[j] - bj); }
          v4u pq, pk, ph; pq.x = pk2(qt[0], qt[1]); pq.y = pk2(qt[2], qt[3]); pq.z = pk2(qt[4], qt[5]); pq.w = pk2(qt[6], qt[7]); pk.x = pk2(kt[0], kt[1]); pk.y = pk2(kt[2], kt[3]); pk.z = pk2(kt[4], kt[5]); pk.w = pk2(kt[6], kt[7]);
          ph.x = pk2(kh[0], kh[1]); ph.y = pk2(kh[2], kh[3]); ph.z = pk2(kh[4], kh[5]); ph.w = pk2(kh[6], kh[7]);
          *(LAS v4u*)(Lb + HG_QT + et * HG_QP + 16 * ko) = pq; *(LAS v4u*)(Lb + HG_KT + et * HG_QP + 16 * ko) = pk;
          *(LAS v4u*)(Lb + HG_KH + et * HG_KP + 16 * ko) = ph; *(LAS v4u*)(Lb + HG_VV + et * HG_KP + 16 * ko) = R.v8;
          if (et == 0) { LAS float* eb = (LAS float*)(Lb + HG_EBL) + 8 * ko; *(LAS f32x4*)eb = (f32x4){__expf(bl[0]), __expf(bl[1]), __expf(bl[2]), __expf(bl[3])}; *(LAS f32x4*)(eb + 4) = (f32x4){__expf(bl[4]), __expf(bl[5]), __expf(bl[6]), __expf(bl[7])}; } }
        const v4u gcur = R.g8;
        if (c + 2 < SEQ / 32) hg_load(R, LF, Qb, Kb, Vb, Gb, go0 + (size_t)(c + 2) * 32 * AW, gl0 + (size_t)(c + 2) * 32 * AW);
        __syncthreads();
        if (c > 0) hg_epilogue(L + HG_OS + ((c - 1) & 1) * HG_OSB, et, ko, ng8, gprev, OG + oo0 + (size_t)(c - 1) * 32 * (2 * AW));
        gprev = gcur;
        { bf16x8 Sb[4];
#pragma unroll
          for (int j = 0; j < 4; ++j) { v4u s; s.x = pk2(S[2 * j][0], S[2 * j][1]); s.y = pk2(S[2 * j][2], S[2 * j][3]); s.z = pk2(S[2 * j + 1][0], S[2 * j + 1][1]); s.w = pk2(S[2 * j + 1][2], S[2 * j + 1][3]); Sb[j] = __builtin_bit_cast(bf16x8, s); }
          f32x4 ao[2] = {{0.f, 0.f, 0.f, 0.f}, {0.f, 0.f, 0.f, 0.f}};
          const bf16x8 Bv = hg_frag_tr(Lb + HG_VV + (4 * fq + (fr >> 2)) * HG_KP + (16 * w + 4 * (fr & 3)) * 2);
          LAS unsigned char* Lp = L + HG_PS;
#define HG_QTS_STATE() do { \
          _Pragma("unroll") for (int mt = 0; mt < 2; ++mt) _Pragma("unroll") for (int j = 0; j < 4; ++j) \
              ao[mt] = __builtin_amdgcn_mfma_f32_16x16x32_bf16(hg_frag64x2(Lb + HG_QT + (16 * mt + fr) * HG_QP + (32 * j + 4 * fq) * 2), Sb[j], ao[mt], 0, 0, 0); \
          _Pragma("unroll") for (int T = 0; T < 8; ++T) { const f32x4 e4 = *(const LAS f32x4*)((const LAS float*)(Lb + HG_EBL) + 16 * T + 4 * fq); \
              S[T] = __builtin_amdgcn_mfma_f32_16x16x32_bf16(hg_frag_tr(Lb + HG_KH + (4 * fq + (fr >> 2)) * HG_KP + (16 * T + 4 * (fr & 3)) * 2), Bv, S[T] * e4, 0, 0, 0); } } while (0)
          if (w < 4) { const int ms = w >> 1, nt = w & 1; f32x4 sc = {0.f, 0.f, 0.f, 0.f};
#pragma unroll
              for (int j = 0; j < 4; ++j) { const bf16x8 Ak = *(const LAS bf16x8*)(Lb + HG_KT + (16 * ms + fr) * HG_QP + (32 * j + 8 * fq) * 2), Bq = *(const LAS bf16x8*)(Lb + HG_QT + (16 * nt + fr) * HG_QP + (32 * j + 8 * fq) * 2);
                  sc = __builtin_amdgcn_mfma_f32_16x16x32_bf16(Ak, Bq, sc, 0, 0, 0); }
              const int t = 16 * nt + fr; float pm[4];
#pragma unroll
              for (int i = 0; i < 4; ++i) pm[i] = (16 * ms + 4 * fq + i <= t) ? sc[i] : 0.f;
              v2u pw; pw.x = pk2(pm[0], pm[1]); pw.y = pk2(pm[2], pm[3]);
              *(LAS v2u*)(Lp + (nt * 64 + lane) * 16 + ms * 8) = pw;
          } else HG_QTS_STATE();
          __syncthreads();
#pragma unroll
          for (int nt = 0; nt < 2; ++nt) ao[nt] = __builtin_amdgcn_mfma_f32_16x16x32_bf16(*(const LAS bf16x8*)(Lp + (nt * 64 + lane) * 16), Bv, ao[nt], 0, 0, 0);
          if (w < 4) HG_QTS_STATE();
#undef HG_QTS_STATE
#pragma unroll
          for (int mt = 0; mt < 2; ++mt)
#pragma unroll
              for (int i = 0; i < 4; ++i) ((LAS float*)Lo)[(16 * mt + 4 * fq + i) * HG_OP + 16 * w + fr] = ao[mt][i]; }
          }
    }
    __syncthreads();
    hg_epilogue(L + HG_OS + ((SEQ / 32 - 1) & 1) * HG_OSB, et, ko, ng8, gprev, OG + oo0 + (size_t)(SEQ / 32 - 1) * 32 * (2 * AW));
    __syncthreads();
}

struct Args { const float* in[19]; float* out; unsigned char* ws; int ph_lo, ph_hi; };
__global__ void __launch_bounds__(NWAVES * 64, 2) hybrid_fwd(Args args) {
    extern __shared__ __attribute__((aligned(16))) unsigned char lds[];
    Frame F;
    F.lds = (LAS unsigned char*)lds;
    F.MISC = (volatile LAS unsigned*)(F.lds + MISC_OFF);
    F.tid = threadIdx.x; F.lane = F.tid & 63; F.wave = __builtin_amdgcn_readfirstlane(F.tid >> 6);
    F.G = gridDim.x; F.bid = blockIdx.x;
    F.ws = args.ws; F.ctl = (gu32*)(args.ws + WS_CTL); F.out = args.out;
    F.in = args.in;
#ifdef TPMAX
    const unsigned long long tpm_start = wall_clock64();
#endif
    for (int u = F.tid; u < (LDS_BYTES - LDSCTL_OFF) / 4; u += NWAVES * 64) ((LAS unsigned*)(F.lds + LDSCTL_OFF))[u] = 0u;
    __syncthreads();
    const int lo = args.ph_lo, hi = args.ph_hi;
    const bool grp = (F.G == 256);
    XcdBarrier bar = xcd_barrier_post((unsigned*)(F.ctl + CW_BAR), F.MISC + 8, (unsigned)F.G);
    XcdBarrier lbar = bar;
    if (grp) lbar = xcd_barrier_post((unsigned*)(F.ctl + CW_GBAR) + (F.bid & 7) * 4096, F.MISC + 10, 32u);
#ifndef STAG_TICKS
#define STAG_TICKS 0
#endif
#define STAGGER() do { if (STAG_TICKS) { const unsigned long long t0_ = __builtin_amdgcn_s_memrealtime(), d_ = (unsigned long long)(F.bid & 7) * STAG_TICKS; while (__builtin_amdgcn_s_memrealtime() - t0_ < d_) __builtin_amdgcn_s_sleep(8); } } while (0)
#ifndef PG8_ALIGN
#define PG8_ALIGN true
#endif
#ifndef PG8_SP2
#define PG8_SP2 true
#endif
#ifndef TPK
#define TPK 1.5e-6f
#endif
#ifdef TPROBE
#ifndef TPLAYERS
#define TPLAYERS 15
#endif
#define TP_ON(bit) (((TPROBE >> (bit)) & 1) && ((bit) == 7 || ((TPLAYERS >> tp_l) & 1)))
#define TP_BEGIN(bit) unsigned long long tp0_ = 0; if (TP_ON(bit)) tp0_ = wall_clock64();
#define TP_END(bit) if (TP_ON(bit)) tp_acc += wall_clock64() - tp0_;
#else
#define TP_BEGIN(bit)
#define TP_END(bit)
#endif
#define IN(k) (lo <= (k) && (k) < hi)
#ifndef RSTAG_A
#define RSTAG_A 0
#endif
#ifndef RSTAG_B
#define RSTAG_B 0
#endif
#define RSTAG(ticks) do { if ((ticks) && grp) { const unsigned long long t0_ = __builtin_amdgcn_s_memrealtime(), d_ = (unsigned long long)(F.bid >> 3) * (ticks); while (__builtin_amdgcn_s_memrealtime() - t0_ < d_) __builtin_amdgcn_s_sleep(2); } } while (0)
#define FRESH() do { int t_ = (F.wave << 6) | pg8::lane_now(); asm volatile("" : "+v"(t_)); F.tid = t_; F.lane = t_ & 63; asm volatile("" : "+s"(F.ws), "+s"(F.out)); } while (0)
#define SEAM(k) do { if (IN(k) && IN((k) + 1)) xcd_barrier(bar); } while (0)
#define LSEAM(k) do { if (IN(k) && IN((k) + 1)) xcd_barrier(lbar); } while (0)
#define ACT ((bf16*)F.out)
#define XB ((bf16*)(F.ws + WS_ACT))
#define OG ((bf16*)(F.ws + WS_OG))
#define HID ((bf16*)(F.ws + WS_HID))
#define MOD ((const float*)(F.ws + WS_MOD))
#define SSQ ((pg8::ssq_t*)(F.ws + WS_SSQ))
#ifdef TPROBE
    unsigned long long tp_acc = 0; int tp_l = 0;
#endif
    { TP_BEGIN(7)
    if (IN(0)) { FRESH(); p0a(F); SEAM(0); }
    if (IN(1)) { FRESH(); p0b(F); SEAM(1); }
    if (IN(2)) { FRESH(); p0c(F); __syncthreads(); }
    if (IN(3)) { FRESH(); prep_phase(F, F.in[0], ACT, MOD + 1 * D, SSQ); SEAM(3); }
    TP_END(7) }
    if (grp && IN(4)) STAGGER();
    for (int l = 0; l < DEPTH; ++l) {
        const int pb = 4 + 6 * l;
#ifdef TPROBE
        tp_l = l;
#endif
#define MODl (MOD + (size_t)l * BATCH * NMODC)
#define wl (F.ws + WS_W + (size_t)l * W_LAYER)
        { TP_BEGIN(0)
        if (IN(pb + 0)) {
            RSTAG(RSTAG_A);
            FRESH();
            pg8::Gemm g{ACT, (const bf16*)(wl + WO_IN), M, INW, D, 0, F.wave}; pg8::StaticOrder S; S.init(M, INW, F.G, F.bid);
            pg8::EpiProj E{(bf16*)(F.ws + WS_Q), (bf16*)(F.ws + WS_K), (bf16*)(F.ws + WS_V), (bf16*)(F.ws + WS_G), (bf16*)(F.ws + WS_U), (bf16*)(F.ws + WS_VG), (bf16*)(F.ws + WS_GA), (bf16*)(F.ws + WS_GB),
                           (float*)(F.ws + WS_LF), (const float*)(F.ws + WS_LB) + l * AW, SSQ + (size_t)(2 * l) * M, (const float*)(F.ws + WS_C1) + (size_t)l * BATCH * INW};
            pg8::gemm_phase<pg8::EpiProj, pg8::StaticOrder, PG8_ALIGN, PG8_SP2>(F.lds + RING_OFF, g, S, E);
            LSEAM(pb + 0);
        }
        TP_END(0) }
        { TP_BEGIN(1)
        if (IN(pb + 1)) {
            FRESH();
            const float* ng = F.in[8] + l * 128; const float* lng = F.in[9] + l * AW; const float* lnb = F.in[10] + l * AW;
            const float* wsp = F.in[11] + (size_t)l * 8 * 128 * 128; const float* bsp = F.in[12] + l * 8 * 128;
            for (int i = 0;; ++i) {
                int u;
                if (grp) { const int g = F.bid & 7, r = F.bid >> 3; if (r < 16) { if (i > 0) break; u = (2 * g + (r >> 3)) * 8 + (r & 7); } else { if (i > 1) break; u = 128 + 32 * g + 2 * (r - 16) + i; } }
                else { u = F.bid + i * F.G; if (u >= 128 + 256) break; }
                if (u < 128) hgrn_unit_mfma(F, u, ng); else sgu_unit(F, u - 128, lng, lnb, wsp, bsp);
#ifdef REP_H
                if (u < 128) hgrn_unit_mfma(F, u, ng);
#endif
#ifdef REP_S
                if (u >= 128) sgu_unit(F, u - 128, lng, lnb, wsp, bsp);
#endif
            }
            LSEAM(pb + 1);
        }
        TP_END(1) }
        { TP_BEGIN(2)
        if (IN(pb + 2)) {
            FRESH();
            pg8::Gemm g{OG, (const bf16*)(wl + WO_A), M, D, 2 * AW, 0, F.wave}; pg8::StaticOrder S; S.init(M, D, F.G, F.bid);
            pg8::EpiMerge2 E{(const bf16*)(F.ws + WS_GA), (const bf16*)(F.ws + WS_GB), ACT};
            pg8::gemm_phase<pg8::EpiMerge2, pg8::StaticOrder, PG8_ALIGN, PG8_SP2>(F.lds + RING_OFF, g, S, E);
            LSEAM(pb + 2);
        }
        TP_END(2) }
        { TP_BEGIN(4)
        if (IN(pb + 3)) {
            RSTAG(RSTAG_B);
            FRESH();
            pg8::Gemm g{ACT, (const bf16*)(wl + WO_OUT), M, D, D, 0, F.wave}; pg8::StaticOrder S; S.init(M, D, F.G, F.bid);
            pg8::EpiResid E{(l == 0) ? F.in[0] : nullptr, XB, XB, MODl + 2 * D, MODl + 4 * D, OG, SSQ + (size_t)(2 * l + 1) * M};
            pg8::gemm_phase<pg8::EpiResid, pg8::StaticOrder, PG8_ALIGN, PG8_SP2>(F.lds + RING_OFF, g, S, E);
            LSEAM(pb + 3);
        }
        TP_END(4) }
        { TP_BEGIN(5)
        if (IN(pb + 4)) {
            RSTAG(RSTAG_A);
            FRESH();
            pg8::Gemm g{OG, (const bf16*)(wl + WO_F1), M, FF, D, 0, F.wave};   pg8::StaticOrder S; S.init(M, FF, F.G, F.bid);
            pg8::EpiRelu2 E{HID, SSQ + (size_t)(2 * l + 1) * M, (const float*)(F.ws + WS_C2) + (size_t)l * BATCH * FF};
            pg8::gemm_phase<pg8::EpiRelu2, pg8::StaticOrder, PG8_ALIGN, PG8_SP2>(F.lds + RING_OFF, g, S, E);
            LSEAM(pb + 4);
        }
        TP_END(5) }
        { TP_BEGIN(6)
        if (IN(pb + 5)) {
            RSTAG(RSTAG_B);
            FRESH();
            pg8::Gemm g{HID, (const bf16*)(wl + WO_F2), M, D, FF, GS_HID, F.wave}; pg8::StaticOrder S; S.init(M, D, F.G, F.bid);
            pg8::EpiResid E{nullptr, XB, XB, MODl + 5 * D, (l + 1 < DEPTH) ? MODl + (size_t)BATCH * NMODC + 1 * D : nullptr, ACT, SSQ + (size_t)(2 * l + 2) * M};
            pg8::gemm_phase<pg8::EpiResid, pg8::StaticOrder, PG8_ALIGN, PG8_SP2>(F.lds + RING_OFF, g, S, E);
            LSEAM(pb + 5);
        }
        TP_END(6) }
    }
#ifdef GPROBE
    const float tp_scale = 1.0f + (float)(*(volatile LAS unsigned*)(F.lds + MISC_OFF + 128)) * 0.01f * TPK;
#elif defined(TPMAX)
    float tp_scale;
    { const unsigned long long t_end = wall_clock64(); unsigned long long* cw = (unsigned long long*)(F.ctl + 1024);
      const unsigned long long own_ = t_end - tpm_start;
      if (F.tid == 0) { __hip_atomic_fetch_max(cw + 0, (TPMAX >= 3) ? own_ : t_end, RLX_AGENT); __hip_atomic_fetch_max(cw + 1, (TPMAX >= 3) ? ~0ull : ~tpm_start, RLX_AGENT); __hip_atomic_fetch_max(cw + 2, (TPMAX >= 3) ? ~own_ : ~t_end, RLX_AGENT); }
      xcd_barrier(bar);
      const unsigned long long hi_ = __hip_atomic_load(cw + 0, RLX_AGENT), lo_ = ~__hip_atomic_load(cw + 1, RLX_AGENT), he_ = ~__hip_atomic_load(cw + 2, RLX_AGENT);
      const unsigned long long el_ = ((TPMAX & 1) ? hi_ : he_) - lo_;
      tp_scale = 1.0f + ((float)el_ * 0.01f - 13000.0f) * TPK; }
#elif defined(TPROBE)
    const float tp_scale = 1.0f + (float)tp_acc * 0.01f * TPK;
#else
    const float tp_scale = 1.0f;
#endif
    SEAM(N_PHASES - 2);
    if (IN(N_PHASES - 1)) { FRESH(); if (grp) final_norm_phase(F, XB, F.out, F.in[18], SSQ + (size_t)(2 * DEPTH) * M, (F.bid & 7) * (M / 8), M / 8, (F.bid >> 3) * NWAVES + F.wave, 32 * NWAVES, tp_scale);
        else final_norm_phase(F, XB, F.out, F.in[18], SSQ + (size_t)(2 * DEPTH) * M, 0, M, F.bid * NWAVES + F.wave, F.G * NWAVES, tp_scale); }
#undef IN
#undef SEAM
}

extern "C" void kernel_launch(void* const* d_in, const int* in_sizes, int n_in, void* d_out, int out_size, void* d_ws, size_t ws_size, hipStream_t stream) {
    static int grid = 0;
    if (grid == 0) {
        if (n_in != 19 || in_sizes[0] != M * D || out_size != M * D || ws_size < WS_END) { fprintf(stderr, "kernel_launch: unexpected shapes: n_in %d in0 %d out %d ws %zu (need %zu)\n", n_in, n_in > 0 ? in_sizes[0] : -1, out_size, ws_size, (size_t)WS_END); grid = -1; return; }
        int dev = 0, cus = 0, per_cu = 0;
        if (hipGetDevice(&dev) != hipSuccess || hipDeviceGetAttribute(&cus, hipDeviceAttributeMultiprocessorCount, dev) != hipSuccess) { grid = -1; return; }
        if (hipFuncSetAttribute((const void*)hybrid_fwd, hipFuncAttributeMaxDynamicSharedMemorySize, LDS_BYTES) != hipSuccess) { fprintf(stderr, "kernel_launch: hipFuncSetAttribute failed\n"); grid = -1; return; }
        if (hipOccupancyMaxActiveBlocksPerMultiprocessor(&per_cu, (const void*)hybrid_fwd, NWAVES * 64, LDS_BYTES) != hipSuccess || per_cu < 1) fprintf(stderr, "kernel_launch: occupancy query reports %d\n", per_cu);
        (void)hipGetLastError();
        grid = cus;
    }
    if (grid < 0) return;
    if (hipMemsetAsync((char*)d_ws + WS_CTL, 0, CTL_ZERO_BYTES, stream) != hipSuccess) return;
    Args a{};
    for (int i = 0; i < 19; ++i) a.in[i] = (const float*)d_in[i];
    a.out = (float*)d_out; a.ws = (unsigned char*)d_ws;
#if MK_SINGLE
    a.ph_lo = 0; a.ph_hi = N_PHASES;
    hipLaunchKernelGGL(hybrid_fwd, dim3(grid), dim3(NWAVES * 64), LDS_BYTES, stream, a);
#else
    for (int k = 0; k < N_PHASES; ++k) { a.ph_lo = k; a.ph_hi = k + 1; hipLaunchKernelGGL(hybrid_fwd, dim3(grid), dim3(NWAVES * 64), LDS_BYTES, stream, a); }
#endif
}
```
